# Optimizing an MI355X kernel written in HIP

```python
import math
import jax, jax.numpy as jnp
from jax import lax
import numpy as np


D_MODEL = 1024
BATCH = 4
SEQ = 8192
DEPTH = 2

GRID_W = 64
CTX_LEN = 256
N_MIXERS = 2
N_DA_LAYERS = (DEPTH + N_MIXERS - 1) // N_MIXERS
N_GLA_LAYERS = DEPTH // N_MIXERS

DA_HEADS = 8
DA_HEAD_DIM = D_MODEL // (2 * DA_HEADS)
DA_Q_BLOCK = 128
ROPE_BASE = 10000.0
ROPE_PAIRS_AXIS = DA_HEAD_DIM // 4

GLA_HEADS = 4
GLA_DK = D_MODEL // 2
GLA_DV = D_MODEL
GLA_DK_HEAD = GLA_DK // GLA_HEADS
GLA_DV_HEAD = GLA_DV // GLA_HEADS
GLA_GATE_RANK = 16
GLA_TAU = 16.0
GLA_CHUNK = 64
GLA_IN = 2 * GLA_DK + 2 * GLA_DV + 2 * GLA_GATE_RANK

N_EXPERTS = 32
TOP_K = 4
D_EXPERT = D_MODEL
SWIGLU_ALPHA = 1.702
SWIGLU_LIMIT = 7.0
MOE_BLOCK = 256

DEEPNORM_ALPHA = (2.0 * DEPTH) ** 0.25
DEEPNORM_BETA = (8.0 * DEPTH) ** -0.25
NORM_EPS = 1e-5

kernel_name = 'hybrid_diffattn_gla_moe_dit'

F32 = jnp.float32


def layer_norm(x, g, b):
    xf = x.astype(F32)
    mu = jnp.mean(xf, -1, keepdims=True)
    xc = xf - mu
    y = xc * lax.rsqrt(jnp.mean(xc * xc, -1, keepdims=True) + NORM_EPS)
    return (y * g + b).astype(x.dtype)


def rms_norm(x, w):
    xf = x.astype(F32)
    y = xf * lax.rsqrt(jnp.mean(xf * xf, -1, keepdims=True) + NORM_EPS)
    return (y * w).astype(x.dtype)


def lambda_init(layer_idx):
    return 0.8 - 0.6 * math.exp(-0.3 * layer_idx)


def axial_rope(L):
    rows = L // GRID_W
    row = jnp.repeat(jnp.arange(rows), GRID_W).astype(F32)
    col = jnp.tile(jnp.arange(GRID_W), rows).astype(F32)
    inv = ROPE_BASE ** (-jnp.arange(ROPE_PAIRS_AXIS, dtype=F32) / ROPE_PAIRS_AXIS)
    ang = jnp.concatenate([row[:, None] * inv, col[:, None] * inv], -1)
    return jnp.cos(ang), jnp.sin(ang)


def apply_rope(x, cos, sin):
    half = x.shape[-1] // 2
    xf = x.astype(F32)
    x1, x2 = xf[..., :half], xf[..., half:]
    cos = cos[None, :, None, None, :]
    sin = sin[None, :, None, None, :]
    return jnp.concatenate([x1 * cos - x2 * sin, x1 * sin + x2 * cos], -1).astype(x.dtype)


def diff_attend(q, k, v, lam):
    s = jnp.einsum('bqhmd,bkhmd->bhmqk', q, k).astype(F32) * (DA_HEAD_DIM ** -0.5)
    p = jax.nn.softmax(s, axis=-1)
    a = p[:, :, 0] - lam * p[:, :, 1]
    return jnp.einsum('bhqk,bkhe->bqhe', a.astype(v.dtype), v)


def diff_attention_mixer(t_lat, t_ctx, w_in, w_out, lam_vecs, subln_w, lam_init, need_ctx):
    def qkv(t):
        bsz, L, _ = t.shape
        q, k, v = jnp.split(t @ w_in, 3, axis=-1)
        return (q.reshape(bsz, L, DA_HEADS, 2, DA_HEAD_DIM),
                k.reshape(bsz, L, DA_HEADS, 2, DA_HEAD_DIM),
                v.reshape(bsz, L, DA_HEADS, 2 * DA_HEAD_DIM))

    def out(o):
        bsz, L = o.shape[:2]
        o = rms_norm(o, subln_w) * (1.0 - lam_init)
        return o.reshape(bsz, L, D_MODEL) @ w_out

    lv = lam_vecs.astype(F32)
    lam = jnp.exp(jnp.sum(lv[0] * lv[1])) - jnp.exp(jnp.sum(lv[2] * lv[3])) + lam_init
    bsz, L, _ = t_lat.shape
    q, k, v = qkv(t_lat)
    cos, sin = axial_rope(L)
    q = apply_rope(q, cos, sin)
    k = apply_rope(k, cos, sin)
    qc, kc, vc = qkv(t_ctx)
    k_all = jnp.concatenate([kc, k], axis=1)
    v_all = jnp.concatenate([vc, v], axis=1)
    nb = L // DA_Q_BLOCK
    q_blocks = jnp.moveaxis(q.reshape(bsz, nb, DA_Q_BLOCK, DA_HEADS, 2, DA_HEAD_DIM), 1, 0)
    o = lax.map(lambda qb: diff_attend(qb, k_all, v_all, lam), q_blocks)
    o = jnp.moveaxis(o, 0, 1).reshape(bsz, L, DA_HEADS, 2 * DA_HEAD_DIM)
    y_lat = out(o)
    y_ctx = out(diff_attend(qc, kc, vc, lam)) if need_ctx else None
    return y_lat, y_ctx


def gla_project(t, w_in, w_gate, b_gate):
    bsz, L, _ = t.shape
    cuts = [GLA_DK, 2 * GLA_DK, 2 * GLA_DK + GLA_DV, 2 * GLA_DK + 2 * GLA_DV,
            2 * GLA_DK + 2 * GLA_DV + GLA_GATE_RANK]
    q, k, v, r, zf, zb = jnp.split(t @ w_in, cuts, axis=-1)

    def heads(a, dh):
        return a.reshape(bsz, L, GLA_HEADS, dh).transpose(0, 2, 1, 3).astype(F32)

    def log_gate(z, d):
        g = jax.nn.log_sigmoid((z @ w_gate[d] + b_gate[d]).astype(F32)) / GLA_TAU
        return heads(g, GLA_DK_HEAD)

    return (heads(q, GLA_DK_HEAD) * (GLA_DK_HEAD ** -0.5), heads(k, GLA_DK_HEAD),
            heads(v, GLA_DV_HEAD), r, log_gate(zf, 0), log_gate(zb, 1))


def gla_chunk_scan(q, k, v, g, s0):
    bsz, h, L, dk = q.shape
    dv = v.shape[-1]
    n = L // GLA_CHUNK
    q, k, g = (a.reshape(bsz, h, n, GLA_CHUNK, dk) for a in (q, k, g))
    v = v.reshape(bsz, h, n, GLA_CHUNK, dv)
    b = jnp.cumsum(g, axis=3)
    b_last = b[:, :, :, -1:, :]
    q_in = q * jnp.exp(b)
    k_in = k * jnp.exp(-b)
    k_state = k * jnp.exp(b_last - b)
    mask = jnp.tril(jnp.ones((GLA_CHUNK, GLA_CHUNK), bool))
    att = jnp.where(mask, jnp.einsum('bhncd,bhnsd->bhncs', q_in, k_in), 0.0)
    o = jnp.einsum('bhncs,bhnse->bhnce', att, v)
    ds = jnp.einsum('bhncd,bhnce->bhnde', k_state, v)
    decay = jnp.exp(b_last[:, :, :, 0, :])

    def step(s, inp):
        dec, d = inp
        return dec[..., None] * s + d, s

    s_final, s_prev = lax.scan(step, s0, (jnp.moveaxis(decay, 2, 0), jnp.moveaxis(ds, 2, 0)))
    o = o + jnp.einsum('bhncd,bhnde->bhnce', q_in, jnp.moveaxis(s_prev, 0, 2))
    return o.reshape(bsz, h, L, dv), s_final


def gla_final_state(k, v, g):
    bc = jnp.cumsum(g, axis=2)
    w = jnp.exp(bc[:, :, -1:, :] - bc)
    return jnp.einsum('bhld,bhle->bhde', k * w, v)


def gla_output(o, r, norm_w, w_out):
    bsz, _, L, _ = o.shape
    o = rms_norm(o, norm_w).transpose(0, 2, 1, 3).reshape(bsz, L, GLA_DV).astype(r.dtype)
    return (o * jax.nn.silu(r)) @ w_out


def gla_mixer(t_lat, t_ctx, w_in, w_gate, b_gate, norm_w, w_out, need_ctx):
    def flip(a):
        return jnp.flip(a, axis=2)

    q, k, v, r, gf, gb = gla_project(t_lat, w_in, w_gate, b_gate)
    qc, kc, vc, rc, gcf, gcb = gla_project(t_ctx, w_in, w_gate, b_gate)
    if need_ctx:
        s0 = jnp.zeros((kc.shape[0], GLA_HEADS, GLA_DK_HEAD, GLA_DV_HEAD), F32)
        ocf, s_f = gla_chunk_scan(qc, kc, vc, gcf, s0)
        ocb, s_b = gla_chunk_scan(flip(qc), flip(kc), flip(vc), flip(gcb), s0)
        y_ctx = gla_output(ocf + flip(ocb), rc, norm_w, w_out)
    else:
        s_f = gla_final_state(kc, vc, gcf)
        s_b = gla_final_state(flip(kc), flip(vc), flip(gcb))
        y_ctx = None
    of, _ = gla_chunk_scan(q, k, v, gf, s_f)
    ob, _ = gla_chunk_scan(flip(q), flip(k), flip(v), flip(gb), s_b)
    y_lat = gla_output(of + flip(ob), r, norm_w, w_out)
    return y_lat, y_ctx


def moe_ffn(h, router_w, router_b, w_gu, b_gu, w_down, b_down):
    T, D = h.shape
    logits = (h @ router_w + router_b).astype(F32)
    top_logit, top_idx = lax.top_k(logits, TOP_K)
    gates = jax.nn.softmax(top_logit, axis=-1)
    n_assign = T * TOP_K
    flat_e = top_idx.reshape(-1)
    order = jnp.argsort(flat_e)
    sorted_e = flat_e[order]
    sorted_tok = order // TOP_K
    sorted_gate = gates.reshape(-1)[order]
    counts = jnp.bincount(flat_e, length=N_EXPERTS)
    padded = (counts + MOE_BLOCK - 1) // MOE_BLOCK * MOE_BLOCK
    start = jnp.cumsum(counts) - counts
    padded_end = jnp.cumsum(padded)
    padded_start = padded_end - padded
    dest = padded_start[sorted_e] + jnp.arange(n_assign) - start[sorted_e]
    n_blocks = -(-n_assign // MOE_BLOCK) + N_EXPERTS
    n_rows = n_blocks * MOE_BLOCK
    row_tok = jnp.full((n_rows,), T, jnp.int32).at[dest].set(sorted_tok.astype(jnp.int32))
    row_gate = jnp.zeros((n_rows,), F32).at[dest].set(sorted_gate)
    block_expert = jnp.minimum(
        jnp.searchsorted(padded_end, jnp.arange(n_blocks) * MOE_BLOCK, side='right'), N_EXPERTS - 1)
    h_pad = jnp.concatenate([h, jnp.zeros((1, D), h.dtype)], axis=0)
    xb = h_pad[row_tok].reshape(n_blocks, MOE_BLOCK, D)

    def expert_block(args):
        xe, e = args
        gu = xe @ w_gu[e] + b_gu[e]
        glu, lin = jnp.split(gu, 2, axis=-1)
        glu = jnp.minimum(glu, SWIGLU_LIMIT)
        lin = jnp.clip(lin, -SWIGLU_LIMIT, SWIGLU_LIMIT)
        act = glu * jax.nn.sigmoid(SWIGLU_ALPHA * glu) * (lin + 1.0)
        return act @ w_down[e] + b_down[e]

    yb = lax.map(expert_block, (xb, block_expert)).reshape(n_rows, D)
    yb = yb * row_gate[:, None].astype(yb.dtype)
    out = jnp.zeros((T + 1, D), yb.dtype).at[row_tok].add(yb)
    return out[:T]


def setup_inputs(seed: int = 0) -> dict:
    key = jax.random.key(seed)
    ks = jax.random.split(key, 23)
    D = D_MODEL

    def nrm(k, shape, scale):
        return jax.random.normal(k, shape, F32) * scale

    return {
        'x': nrm(ks[0], (BATCH, SEQ, D), 1.0),
        'c': nrm(ks[1], (BATCH, D), 1.0),
        'ctx': nrm(ks[2], (BATCH, CTX_LEN, D), 1.0),
        'c_ctx': nrm(ks[3], (D,), 1.0),
        'ada_w': nrm(ks[4], (DEPTH, D, 6 * D), D ** -0.5),
        'ada_b': nrm(ks[5], (DEPTH, 6 * D), 0.02),
        'ln_g': 1.0 + nrm(ks[6], (DEPTH, 2, D), 0.02),
        'ln_b': nrm(ks[7], (DEPTH, 2, D), 0.02),
        'da_w_in': nrm(ks[8], (N_DA_LAYERS, D, 3 * D), D ** -0.5),
        'da_w_out': nrm(ks[9], (N_DA_LAYERS, D, D), D ** -0.5 * DEEPNORM_BETA),
        'da_lambda': nrm(ks[10], (N_DA_LAYERS, 4, DA_HEAD_DIM), 0.1),
        'da_subln_w': 1.0 + nrm(ks[11], (N_DA_LAYERS, 2 * DA_HEAD_DIM), 0.02),
        'gla_w_in': nrm(ks[12], (N_GLA_LAYERS, D, GLA_IN), D ** -0.5),
        'gla_w_gate': nrm(ks[13], (N_GLA_LAYERS, 2, GLA_GATE_RANK, GLA_DK), GLA_GATE_RANK ** -0.5),
        'gla_b_gate': nrm(ks[14], (N_GLA_LAYERS, 2, GLA_DK), 0.1),
        'gla_norm_w': 1.0 + nrm(ks[15], (N_GLA_LAYERS, GLA_DV_HEAD), 0.02),
        'gla_w_out': nrm(ks[16], (N_GLA_LAYERS, GLA_DV, D), GLA_DV ** -0.5 * DEEPNORM_BETA),
        'router_w': nrm(ks[17], (DEPTH, D, N_EXPERTS), D ** -0.5),
        'router_b': nrm(ks[18], (DEPTH, N_EXPERTS), 0.01),
        'moe_w_gu': nrm(ks[19], (DEPTH, N_EXPERTS, D, 2 * D_EXPERT), D ** -0.5),
        'moe_b_gu': nrm(ks[20], (DEPTH, N_EXPERTS, 2 * D_EXPERT), 0.01),
        'moe_w_down': nrm(ks[21], (DEPTH, N_EXPERTS, D_EXPERT, D), D_EXPERT ** -0.5 * DEEPNORM_BETA),
        'moe_b_down': nrm(ks[22], (DEPTH, N_EXPERTS, D), 0.01),
    }


def reference(x, c, ctx, c_ctx, ada_w, ada_b, ln_g, ln_b, da_w_in, da_w_out, da_lambda,
              da_subln_w, gla_w_in, gla_w_gate, gla_b_gate, gla_norm_w, gla_w_out,
              router_w, router_b, moe_w_gu, moe_b_gu, moe_w_down, moe_b_down):
    bsz, seq, _ = x.shape
    n_ctx = ctx.shape[1]
    silu_c = jax.nn.silu(c)
    silu_cc = jax.nn.silu(c_ctx)
    for i in range(DEPTH):
        last = i == DEPTH - 1
        sh1, sc1, g1, sh2, sc2, g2 = jnp.split((silu_c @ ada_w[i] + ada_b[i])[:, None, :], 6, axis=-1)
        csh1, csc1, cg1, csh2, csc2, cg2 = jnp.split(silu_cc @ ada_w[i] + ada_b[i], 6, axis=-1)
        t_lat = x * (1.0 + sc1) + sh1
        t_ctx = ctx * (1.0 + csc1) + csh1
        j = i // N_MIXERS
        if i % N_MIXERS == 0:
            y_lat, y_ctx = diff_attention_mixer(t_lat, t_ctx, da_w_in[j], da_w_out[j], da_lambda[j],
                                                da_subln_w[j], lambda_init(i), not last)
        else:
            y_lat, y_ctx = gla_mixer(t_lat, t_ctx, gla_w_in[j], gla_w_gate[j], gla_b_gate[j],
                                     gla_norm_w[j], gla_w_out[j], not last)
        x = layer_norm(DEEPNORM_ALPHA * x + g1 * y_lat, ln_g[i, 0], ln_b[i, 0])
        u_lat = (x * (1.0 + sc2) + sh2).reshape(-1, D_MODEL)
        if last:
            f_lat = moe_ffn(u_lat, router_w[i], router_b[i], moe_w_gu[i], moe_b_gu[i],
                            moe_w_down[i], moe_b_down[i])
        else:
            ctx = layer_norm(DEEPNORM_ALPHA * ctx + cg1 * y_ctx, ln_g[i, 0], ln_b[i, 0])
            u_ctx = (ctx * (1.0 + csc2) + csh2).reshape(-1, D_MODEL)
            f = moe_ffn(jnp.concatenate([u_lat, u_ctx], axis=0), router_w[i], router_b[i],
                        moe_w_gu[i], moe_b_gu[i], moe_w_down[i], moe_b_down[i])
            f_lat = f[:bsz * seq]
            ctx = layer_norm(DEEPNORM_ALPHA * ctx + cg2 * f[bsz * seq:].reshape(bsz, n_ctx, D_MODEL),
                             ln_g[i, 1], ln_b[i, 1])
        x = layer_norm(DEEPNORM_ALPHA * x + g2 * f_lat.reshape(bsz, seq, D_MODEL), ln_g[i, 1], ln_b[i, 1])
    return x
```

```cpp
#include <hip/hip_runtime.h>
#include <cstdio>
#include <cstdint>

#ifndef MK_MAX_PHASE
#define MK_MAX_PHASE 20
#endif
#ifndef MK_PER_PHASE
#define MK_PER_PHASE 0
#endif

#define LAS __attribute__((address_space(3)))
typedef unsigned short bf16_t;
typedef short bf16x8 __attribute__((ext_vector_type(8)));
typedef short s16x4 __attribute__((ext_vector_type(4)));
typedef float f32x2 __attribute__((ext_vector_type(2)));
typedef float f32x4 __attribute__((ext_vector_type(4)));
typedef float f32x16 __attribute__((ext_vector_type(16)));
typedef unsigned u32x2 __attribute__((ext_vector_type(2)));
typedef unsigned u32x4 __attribute__((ext_vector_type(4)));

constexpr int DM = 1024, NB = 4, SEQ = 8192, NCTX = 256;
constexpr int TLAT = NB * SEQ, TCTX = NB * NCTX, T0 = TLAT + TCTX;
constexpr int KVLEN = NCTX + SEQ;
constexpr int NEXP = 32, TOPK = 4;
constexpr int MAXRB = 560;
constexpr int GIN_N = 3104, GIN_NP = 3328;
constexpr int NPC = 132;
constexpr float ALPHA = 1.4142135623730951f;
constexpr float NORM_EPS = 1e-5f;
constexpr float QSCALE = 0.125f * 1.4426950408889634f;
constexpr float LAM_INIT0 = 0.2f;
constexpr int NPHASE = 20;

constexpr size_t MiB = 1u << 20;
constexpr size_t WS_CTL = 0;
constexpr size_t CTL_ZERO_BYTES = 64 * 1024;
constexpr size_t WS_MOD = 1 * MiB;
constexpr size_t WS_ROPE = WS_MOD + 256 * 1024;
constexpr size_t WS_HIST = WS_ROPE + 16 * 1024;
constexpr size_t WS_BLKEXP = WS_HIST + 32 * 1024;
constexpr size_t WS_TOKE = 2 * MiB;
constexpr size_t WS_TOKG = WS_TOKE + 1 * MiB;
constexpr size_t WS_TOKR = WS_TOKG + 1 * MiB;
constexpr size_t WS_GZ = 6 * MiB;
constexpr size_t WS_DEC = 11 * MiB;
constexpr size_t WS_WQKV = 14 * MiB;
constexpr size_t WS_WO = WS_WQKV + 6 * MiB;
constexpr size_t WS_WGIN = WS_WO + 2 * MiB;
constexpr size_t WS_WGOUT = WS_WGIN + 7 * MiB;
constexpr size_t WS_WGU = 32 * MiB;
constexpr size_t WS_WD = WS_WGU + 256 * MiB;
constexpr size_t ACT = (size_t)T0 * DM * 2;
constexpr size_t WS_T = WS_WD + 128 * MiB;
constexpr size_t WS_Q = WS_T + ACT;
constexpr size_t WS_KC = WS_Q + ACT;
constexpr size_t WS_VC = WS_KC + ACT;
constexpr size_t WS_AO = WS_VC + ACT;
constexpr size_t WS_Y = WS_AO + ACT;
constexpr size_t WS_U = WS_Y + ACT;
constexpr size_t WS_X1 = WS_U + ACT;
constexpr size_t WS_X2 = WS_X1 + 2 * ACT;
constexpr size_t XSB = (size_t)MAXRB * 256 * DM * 2;
constexpr size_t WS_XS = WS_X2 + 2 * ACT;
constexpr size_t WS_H = WS_XS + XSB;
constexpr size_t WS_END = WS_H + XSB;

constexpr int LDS_MAIN = 131072;
constexpr int LDS_MISC = LDS_MAIN;
constexpr int LDS_BYTES = LDS_MAIN + 8192;

typedef __bf16 bf16x2_t __attribute__((ext_vector_type(2)));
__device__ __forceinline__ unsigned cvt_pk_bf16(float lo, float hi) { const f32x2 v = {lo, hi}; const bf16x2_t b = __builtin_convertvector(v, bf16x2_t); return __builtin_bit_cast(unsigned, b); }
__device__ __forceinline__ float bf2f(unsigned short b) { return __builtin_bit_cast(float, (unsigned)b << 16); }
__device__ __forceinline__ float bflo(unsigned w) { return __builtin_bit_cast(float, w << 16); }
__device__ __forceinline__ float bfhi(unsigned w) { return __builtin_bit_cast(float, w & 0xffff0000u); }
__device__ __forceinline__ float wave_sum(float v) {
#pragma unroll
    for (int o = 1; o < 64; o <<= 1) v += __shfl_xor(v, o);
    return v;
}
__device__ __forceinline__ float siluf(float x) { return x / (1.f + __expf(-x)); }
__device__ __forceinline__ float logsigf(float x) { return fminf(x, 0.f) - log1pf(expf(-fabsf(x))); }
__device__ __forceinline__ int crow(int r, int hi) { return (r & 3) + 8 * (r >> 2) + 4 * hi; }
#define LDS_WAIT() asm volatile("s_waitcnt lgkmcnt(0)" ::: "memory")
#define SBAR() __builtin_amdgcn_sched_barrier(0)

#define XB_TMO      128
#define XB_XCNT(j)  (256  + 64 * (j))
#define XB_XSUB(j)  (1280 + 64 * (j))
#define XB_XGEN(j)  (2304 + 64 * (j))
#define XB_TOP      3328
#define XB_TOPGEN   3392
#define XCD_BAR_WORDS 3456
#define XB_SPIN_CAP (1u << 18)
__device__ __forceinline__ unsigned xb_ld(unsigned* p)              { return __hip_atomic_load(p, __ATOMIC_RELAXED, __HIP_MEMORY_SCOPE_AGENT); }
__device__ __forceinline__ unsigned xb_add(unsigned* p, unsigned v) { return __hip_atomic_fetch_add(p, v, __ATOMIC_RELAXED, __HIP_MEMORY_SCOPE_AGENT); }
__device__ __forceinline__ unsigned xb_xcc_id() { return (unsigned)__builtin_amdgcn_s_getreg((3 << 11) | 20) & 0xFu; }
#define XB_SPIN(cond, bar) do { unsigned _sp = 0; while (cond) { __builtin_amdgcn_s_sleep(1); \
    if ((++_sp & 255u) == 0u) { if (xb_ld(&(bar)[XB_TMO])) break; if (_sp > XB_SPIN_CAP) { atomicAdd(&(bar)[XB_TMO], 1u); break; } } } } while (0)
struct XcdBarrier { unsigned* bar; unsigned x; volatile LAS unsigned* st; };
__device__ __forceinline__ XcdBarrier xcd_barrier_post(unsigned* bar, volatile LAS unsigned* st) {
    XcdBarrier b; b.bar = bar; b.x = xb_xcc_id(); b.st = st;
    if (threadIdx.x == 0) (void)xb_add(&bar[XB_XCNT(b.x)], 1u);
    return b;
}
__device__ __forceinline__ void xcd_barrier_complete(unsigned* bar, unsigned x, unsigned& nloc, unsigned& nx) {
    const unsigned G = gridDim.x * gridDim.y * gridDim.z;
    unsigned sum, cnt, mine, sp = 0u;
    for (;;) {
        sum = 0u; cnt = 0u; mine = 0u;
#pragma unroll
        for (unsigned j = 0; j < 16; ++j) { const unsigned c = xb_ld(&bar[XB_XCNT(j)]); sum += c; cnt += (c > 0u) ? 1u : 0u; mine = (j == x) ? c : mine; }
        if (sum == G) break;
        __builtin_amdgcn_s_sleep(1);
        if ((++sp & 255u) == 0u) { if (xb_ld(&bar[XB_TMO])) break; if (sp > XB_SPIN_CAP) { atomicAdd(&bar[XB_TMO], 1u); break; } }
    }
    nloc = mine > 0u ? mine : 1u; nx = cnt > 0u ? cnt : 1u;
}
__device__ __forceinline__ void xcd_barrier(const XcdBarrier& b) {
    asm volatile("s_waitcnt vmcnt(0)" ::: "memory");
    __syncthreads();
    if (threadIdx.x == 0) {
        unsigned* bar = b.bar;
        __builtin_amdgcn_s_waitcnt(0);
        unsigned nloc = b.st[0], nx = b.st[1];
        if (nloc == 0u) { xcd_barrier_complete(bar, b.x, nloc, nx); b.st[0] = nloc; b.st[1] = nx; }
        const unsigned old = xb_add(&bar[XB_XSUB(b.x)], 1u);
        const unsigned gen = old / nloc;
        if (old + 1u == (gen + 1u) * nloc) {
            __builtin_amdgcn_fence(__ATOMIC_RELEASE, "agent");
            asm volatile("s_waitcnt vmcnt(0)" ::: "memory");
            const unsigned og = xb_add(&bar[XB_TOP], 1u);
            const unsigned tg = og / nx;
            if (og + 1u == (tg + 1u) * nx) xb_add(&bar[XB_TOPGEN], 1u);
            else XB_SPIN(xb_ld(&bar[XB_TOPGEN]) == tg, bar);
            __builtin_amdgcn_fence(__ATOMIC_ACQUIRE, "agent");
            xb_add(&bar[XB_XGEN(b.x)], 1u);
            asm volatile("s_waitcnt vmcnt(0)" ::: "memory");
        } else {
            XB_SPIN(xb_ld(&bar[XB_XGEN(b.x)]) == gen, bar);
            __builtin_amdgcn_fence(__ATOMIC_ACQUIRE, "agent");
            asm volatile("s_waitcnt vmcnt(0)" ::: "memory");
        }
    }
    __syncthreads();
}

namespace pg8 {
constexpr int BM = 256, BK = 64, HALF = 128, HTB = HALF * BK * 2, STAGE_BYTES = 8 * HTB, NXCD = 8, WGM = 8, K = 1024;
__host__ __device__ __forceinline__ int lds_byte(int r, int c) { const int st = (r >> 4) * 2 + (c >> 5), rr = r & 15, cc = c & 31, ob = rr * 64 + cc * 2; return st * 1024 + (ob ^ (((ob >> 9) & 1) << 5)); }
__host__ __device__ __forceinline__ void stage_rc(int b, int& R, int& C) { const int st = b / 1024, sb = b % 1024, swz = sb ^ (((sb >> 9) & 1) << 5); R = (st >> 1) * 16 + swz / 64; C = (st & 1) * 32 + (swz % 64) / 2; }
__host__ __device__ __forceinline__ int perm32(int rho) { const int n = rho >> 4, i = rho & 15; return 8 * (i >> 2) + 4 * n + (i & 3); }
struct Unit { int pm, pn, e; };
constexpr size_t TSTEP = (size_t)BM * K * 2;

struct DenseOrder {
    const char* A; const char* Bt; int nM, nN, nwg, G, c;
    __device__ void init(const void* A_, const void* Bt_, int M, int N, int G_, int c_) { A = (const char*)A_; Bt = (const char*)Bt_; nM = M / BM; nN = N / BM; nwg = nM * nN; G = G_; c = c_; }
    __device__ bool next(int i, Unit& u) const {
        const long L = (long)i * G + c; if (L >= nwg) return false;
        int wgid = (int)L; { const int q = nwg / NXCD, r = nwg % NXCD, xcd = wgid % NXCD, off = wgid / NXCD; wgid = (xcd < r ? xcd * (q + 1) : r * (q + 1) + (xcd - r) * q) + off; }
        const int nig = WGM * nN, gid = wgid / nig, fm = gid * WGM, gsz = (nM - fm) < WGM ? (nM - fm) : WGM;
        u.pm = fm + ((wgid % nig) % gsz); u.pn = (wgid % nig) / gsz; u.e = 0; return true;
    }
    __device__ __forceinline__ const char* a_base(const Unit& u) const { return A + (size_t)u.pm * TSTEP; }
    __device__ __forceinline__ const char* b_base(const Unit& u) const { return Bt + (size_t)u.pn * TSTEP; }
};
struct MoeOrder {
    const char* A; const char* Bt; const int* blkexp; int ncol, nunits, G, c;
    __device__ void init(const void* A_, const void* Bt_, const int* blkexp_, int nblk, int ncol_, int G_, int c_) { A = (const char*)A_; Bt = (const char*)Bt_; blkexp = blkexp_; ncol = ncol_; nunits = nblk * ncol_; G = G_; c = c_; }
    __device__ bool next(int i, Unit& u) const {
        const long L = (long)i * G + c; if (L >= nunits) return false;
        u.pm = (int)(L / ncol); u.pn = (int)(L % ncol); u.e = __builtin_amdgcn_readfirstlane(blkexp[u.pm]); return true;
    }
    __device__ __forceinline__ const char* a_base(const Unit& u) const { return A + (size_t)u.pm * TSTEP; }
    __device__ __forceinline__ const char* b_base(const Unit& u) const { return Bt + ((size_t)u.e * ncol + u.pn) * TSTEP; }
};

template <class Epi, class Sched, bool ALIGN_EPI, bool SP2>
__device__ __forceinline__ void gemm_phase(LAS unsigned char* lds, const Sched& S, const Epi& E) {
    const int tid = threadIdx.x, wid = __builtin_amdgcn_readfirstlane(tid >> 6), lane = tid & 63, wr = wid >> 2, wc = wid & 3, fr = lane & 15, fq = lane >> 4;
    constexpr int nt = K / BK;
    unsigned voffA[2], voffB[2];
#pragma unroll
    for (int i = 0; i < 2; ++i) { int R, C; stage_rc(tid * 16 + i * 8192, R, C); const int Rb = (R & ~31) + perm32(R & 31);
        voffA[i] = (unsigned)(R * K + C) * 2u; voffB[i] = (unsigned)(Rb * K + C) * 2u; }
    constexpr size_t kstep = (size_t)(BK * 2);
    constexpr size_t hstep = (size_t)HALF * K * 2;
    const unsigned ldsw = (unsigned)wid * 1024u;
    const int aoff = lds_byte(wr * 64 + fr, fq * 8), boff = lds_byte(wc * 32 + fr, fq * 8);
#define PG8_SA(b, h) (((b) * 2 + (h)) * HTB)
#define PG8_SB(b, h) ((4 + (b) * 2 + (h)) * HTB)
#define PG8_STAGE(bufoff, gbase, voff) do { _Pragma("unroll") for (int _i = 0; _i < 2; ++_i) \
        __builtin_amdgcn_global_load_lds((const unsigned*)((const char*)(gbase) + (voff)[_i]), (LAS unsigned*)(lds + (bufoff) + ldsw + _i * 8192), 16, 0, 0); } while (0)
#define PG8_LDA(dst, b, h) do { _Pragma("unroll") for (int m = 0; m < 4; ++m) _Pragma("unroll") for (int k = 0; k < 2; ++k) dst[m][k] = *(const LAS bf16x8*)(lds + PG8_SA(b, h) + aoff + m * 2048 + k * 1024); } while (0)
#define PG8_LDB(dst, b, h) do { _Pragma("unroll") for (int n = 0; n < 2; ++n) _Pragma("unroll") for (int k = 0; k < 2; ++k) dst[n][k] = *(const LAS bf16x8*)(lds + PG8_SB(b, h) + boff + n * 2048 + k * 1024); } while (0)
#define PG8_MMA(ai, bj, At, Bt) do { __builtin_amdgcn_s_setprio(1); _Pragma("unroll") for (int m = 0; m < 4; ++m) _Pragma("unroll") for (int n = 0; n < 2; ++n) _Pragma("unroll") for (int k = 0; k < 2; ++k) \
        acc[ai][bj][m][n] = __builtin_amdgcn_mfma_f32_16x16x32_bf16(Bt[n][k], At[m][k], acc[ai][bj][m][n], 0, 0, 0); __builtin_amdgcn_s_setprio(0); } while (0)
#define PG8_WAIT_V(n) asm volatile("s_waitcnt vmcnt(" #n ")" ::: "memory")
#define PG8_WAIT_L(n) asm volatile("s_waitcnt lgkmcnt(" #n ")" ::: "memory")
#define PG8_BAR __builtin_amdgcn_s_barrier()
#define PG8_SCHED __builtin_amdgcn_sched_barrier(0)
    Unit cur, nxt; int ui = 0;
    if (!S.next(0, cur)) return;
    f32x4 acc[2][2][4][2];
#pragma unroll
    for (int a = 0; a < 2; ++a)
#pragma unroll
        for (int b = 0; b < 2; ++b)
#pragma unroll
            for (int m = 0; m < 4; ++m)
#pragma unroll
                for (int n = 0; n < 2; ++n) acc[a][b][m][n] = (f32x4){0.f, 0.f, 0.f, 0.f};
    bf16x8 At[4][2], B0[2][2], B1[2][2];
    const char* cA = S.a_base(cur); const char* cB = S.b_base(cur);
    if constexpr (SP2) {
        PG8_STAGE(PG8_SB(0, 0), cB, voffB); PG8_STAGE(PG8_SB(0, 1), cB + hstep, voffB); PG8_STAGE(PG8_SA(0, 0), cA, voffA); PG8_STAGE(PG8_SA(0, 1), cA + hstep, voffA);
        if (wr == 1) PG8_BAR;
        PG8_WAIT_V(2); PG8_BAR;
        PG8_STAGE(PG8_SB(1, 0), cB + kstep, voffB); PG8_STAGE(PG8_SA(1, 0), cA + kstep, voffA); PG8_STAGE(PG8_SB(1, 1), cB + hstep + kstep, voffB);
        PG8_WAIT_V(6); PG8_BAR;
    } else {
        PG8_STAGE(PG8_SB(0, 0), cB, voffB); PG8_STAGE(PG8_SA(0, 0), cA, voffA); PG8_STAGE(PG8_SB(0, 1), cB + hstep, voffB); PG8_STAGE(PG8_SA(0, 1), cA + hstep, voffA);
        if (wr == 1) PG8_BAR;
        PG8_WAIT_V(4); PG8_BAR;
        PG8_STAGE(PG8_SB(1, 0), cB + kstep, voffB); PG8_STAGE(PG8_SA(1, 0), cA + kstep, voffA); PG8_STAGE(PG8_SB(1, 1), cB + hstep + kstep, voffB);
        PG8_WAIT_V(6); PG8_BAR;
    }
    for (;;) {
        const bool has_next = S.next(ui + 1, nxt);
        const char* nA = has_next ? S.a_base(nxt) : cA; const char* nB = has_next ? S.b_base(nxt) : cB;
        for (int t = 0; t < nt; t += 2) {
            const bool last = (t == nt - 2);
            const char* a1 = cA + (size_t)(t + 1) * kstep;
            const char* a2 = last ? nA : cA + (size_t)(t + 2) * kstep; const char* b2 = last ? nB : cB + (size_t)(t + 2) * kstep;
            const char* a3 = a2 + kstep; const char* b3 = b2 + kstep;
            if constexpr (SP2) {
            PG8_LDB(B0, 0, 0); PG8_LDB(B1, 0, 1); PG8_SCHED; PG8_LDA(At, 0, 0); PG8_STAGE(PG8_SA(1, 1), a1 + hstep, voffA);
            PG8_WAIT_V(8); PG8_WAIT_L(0); PG8_BAR; PG8_MMA(0, 0, At, B0); PG8_MMA(0, 1, At, B1); PG8_BAR; PG8_SCHED;
            PG8_LDA(At, 0, 1); PG8_STAGE(PG8_SB(0, 0), b2, voffB); PG8_STAGE(PG8_SB(0, 1), b2 + hstep, voffB); PG8_STAGE(PG8_SA(0, 0), a2, voffA);
            PG8_WAIT_V(8); PG8_WAIT_L(0); PG8_BAR; PG8_MMA(1, 0, At, B0); PG8_MMA(1, 1, At, B1); PG8_BAR; PG8_SCHED;
            PG8_LDB(B0, 1, 0); PG8_LDB(B1, 1, 1); PG8_SCHED; PG8_LDA(At, 1, 0); PG8_STAGE(PG8_SA(0, 1), a2 + hstep, voffA);
            PG8_WAIT_V(8); PG8_WAIT_L(0); PG8_BAR; PG8_MMA(0, 0, At, B0); PG8_MMA(0, 1, At, B1); PG8_BAR; PG8_SCHED;
            PG8_LDA(At, 1, 1); PG8_STAGE(PG8_SB(1, 0), b3, voffB); PG8_STAGE(PG8_SB(1, 1), b3 + hstep, voffB); PG8_STAGE(PG8_SA(1, 0), a3, voffA);
            PG8_WAIT_V(8); PG8_WAIT_L(0); PG8_BAR; PG8_MMA(1, 0, At, B0); PG8_MMA(1, 1, At, B1); PG8_BAR; PG8_SCHED;
            } else {
            PG8_LDB(B0, 0, 0); PG8_SCHED; PG8_LDA(At, 0, 0); PG8_STAGE(PG8_SA(1, 1), a1 + hstep, voffA);
            PG8_WAIT_L(8); PG8_BAR; PG8_WAIT_L(0); PG8_MMA(0, 0, At, B0); PG8_BAR; PG8_SCHED;
            PG8_LDB(B1, 0, 1); PG8_STAGE(PG8_SB(0, 0), b2, voffB);
            PG8_BAR; PG8_WAIT_L(0); PG8_MMA(0, 1, At, B1); PG8_BAR;
            PG8_LDA(At, 0, 1); PG8_STAGE(PG8_SA(0, 0), a2, voffA);
            PG8_BAR; PG8_WAIT_L(0); PG8_MMA(1, 0, At, B0); PG8_BAR; PG8_SCHED;
            PG8_STAGE(PG8_SB(0, 1), b2 + hstep, voffB);
            PG8_WAIT_V(6); PG8_BAR; PG8_MMA(1, 1, At, B1); PG8_BAR;
            PG8_LDB(B0, 1, 0); PG8_SCHED; PG8_LDA(At, 1, 0); PG8_STAGE(PG8_SA(0, 1), a2 + hstep, voffA);
            PG8_WAIT_L(8); PG8_BAR; PG8_WAIT_L(0); PG8_MMA(0, 0, At, B0); PG8_BAR; PG8_SCHED;
            PG8_LDB(B1, 1, 1); PG8_STAGE(PG8_SB(1, 0), b3, voffB);
            PG8_BAR; PG8_WAIT_L(0); PG8_MMA(0, 1, At, B1); PG8_BAR;
            PG8_LDA(At, 1, 1); PG8_STAGE(PG8_SA(1, 0), a3, voffA);
            PG8_BAR; PG8_WAIT_L(0); PG8_MMA(1, 0, At, B0); PG8_BAR; PG8_SCHED;
            PG8_STAGE(PG8_SB(1, 1), b3 + hstep, voffB);
            PG8_WAIT_V(6); PG8_BAR; PG8_MMA(1, 1, At, B1); PG8_BAR;
            }
        }
        if constexpr (ALIGN_EPI) { if (wr == 0) PG8_BAR; }
        E(acc, cur, wr, wc, fr, fq);
        if (!has_next) break;
#pragma unroll
        for (int a = 0; a < 2; ++a)
#pragma unroll
            for (int b = 0; b < 2; ++b)
#pragma unroll
                for (int m = 0; m < 4; ++m)
#pragma unroll
                    for (int n = 0; n < 2; ++n) acc[a][b][m][n] = (f32x4){0.f, 0.f, 0.f, 0.f};
        cur = nxt; cA = nA; cB = nB; ++ui;
        if constexpr (ALIGN_EPI) { if (wr == 1) PG8_BAR; }
    }
    PG8_WAIT_V(0);
    if constexpr (!ALIGN_EPI) { if (wr == 0) PG8_BAR; }
    PG8_BAR;
#undef PG8_SA
#undef PG8_SB
#undef PG8_STAGE
#undef PG8_LDA
#undef PG8_LDB
#undef PG8_MMA
#undef PG8_WAIT_V
#undef PG8_WAIT_L
#undef PG8_BAR
#undef PG8_SCHED
}

__device__ __forceinline__ void st8bf(bf16_t* p, const f32x4& v0, const f32x4& v1) {
    u32x4 o; o.x = cvt_pk_bf16(v0[0], v0[1]); o.y = cvt_pk_bf16(v0[2], v0[3]); o.z = cvt_pk_bf16(v1[0], v1[1]); o.w = cvt_pk_bf16(v1[2], v1[3]);
    *(u32x4*)p = o;
}

struct EpiQKV {
    bf16_t* Q; bf16_t* KC; bf16_t* VC; const float* rope;
    __device__ __forceinline__ void operator()(const f32x4 (&acc)[2][2][4][2], const Unit& u, int wr, int wc, int fr, int fq) const {
        const int pm = u.pm, pn = u.pn;
        const bool lat = pm < 128;
        const int b = lat ? (pm >> 5) : (pm - 128);
        const int posb = lat ? ((pm & 31) << 8) : 0;
        const size_t kvrow0 = (size_t)b * KVLEN + (lat ? (NCTX + posb) : 0);
        const size_t qrow0 = (size_t)pm * 256;
        if (pn < 8) {
            const int sec = pn >> 2;
            const int blk = 4 * (pn & 3) + wc;
            const float scl = sec == 0 ? QSCALE : 1.f;
#pragma unroll
            for (int ai = 0; ai < 2; ++ai)
#pragma unroll
                for (int m = 0; m < 4; ++m) {
                    const int lr = 128 * ai + 64 * wr + 16 * m + fr;
                    f32x4 cs0 = {1.f, 0.f, 1.f, 0.f}, cs1 = cs0, cs2 = cs0, cs3 = cs0;
                    if (lat) { const int pos = posb + lr; const int v = (fq < 2) ? (pos >> 6) : (pos & 63);
                        const f32x4* rp = (const f32x4*)(rope + (size_t)(v * 16 + (fq & 1) * 8) * 2);
                        cs0 = rp[0]; cs1 = rp[1]; cs2 = rp[2]; cs3 = rp[3]; }
                    const f32x4 a0 = acc[ai][0][m][0], a1 = acc[ai][0][m][1], b0 = acc[ai][1][m][0], b1 = acc[ai][1][m][1];
                    f32x4 o1a, o1b, o2a, o2b;
                    o1a[0] = (a0[0] * cs0[0] - b0[0] * cs0[1]) * scl; o2a[0] = (a0[0] * cs0[1] + b0[0] * cs0[0]) * scl;
                    o1a[1] = (a0[1] * cs0[2] - b0[1] * cs0[3]) * scl; o2a[1] = (a0[1] * cs0[3] + b0[1] * cs0[2]) * scl;
                    o1a[2] = (a0[2] * cs1[0] - b0[2] * cs1[1]) * scl; o2a[2] = (a0[2] * cs1[1] + b0[2] * cs1[0]) * scl;
                    o1a[3] = (a0[3] * cs1[2] - b0[3] * cs1[3]) * scl; o2a[3] = (a0[3] * cs1[3] + b0[3] * cs1[2]) * scl;
                    o1b[0] = (a1[0] * cs2[0] - b1[0] * cs2[1]) * scl; o2b[0] = (a1[0] * cs2[1] + b1[0] * cs2[0]) * scl;
                    o1b[1] = (a1[1] * cs2[2] - b1[1] * cs2[3]) * scl; o2b[1] = (a1[1] * cs2[3] + b1[1] * cs2[2]) * scl;
                    o1b[2] = (a1[2] * cs3[0] - b1[2] * cs3[1]) * scl; o2b[2] = (a1[2] * cs3[1] + b1[2] * cs3[0]) * scl;
                    o1b[3] = (a1[3] * cs3[2] - b1[3] * cs3[3]) * scl; o2b[3] = (a1[3] * cs3[3] + b1[3] * cs3[2]) * scl;
                    bf16_t* rowp = (sec == 0 ? Q + (qrow0 + lr) * DM : KC + (kvrow0 + lr) * DM) + 64 * blk + 8 * fq;
                    st8bf(rowp, o1a, o1b); st8bf(rowp + 32, o2a, o2b);
                }
        } else {
            const int col0 = 256 * (pn - 8) + 32 * wc + 8 * fq;
#pragma unroll
            for (int ai = 0; ai < 2; ++ai)
#pragma unroll
                for (int m = 0; m < 4; ++m) {
                    const int lr = 128 * ai + 64 * wr + 16 * m + fr;
                    bf16_t* rowp = VC + (kvrow0 + lr) * DM + col0;
                    st8bf(rowp, acc[ai][0][m][0], acc[ai][0][m][1]); st8bf(rowp + 128, acc[ai][1][m][0], acc[ai][1][m][1]);
                }
        }
    }
};
struct EpiPlain {
    bf16_t* O;
    __device__ __forceinline__ void operator()(const f32x4 (&acc)[2][2][4][2], const Unit& u, int wr, int wc, int fr, int fq) const {
        const int col0 = 256 * u.pn + 32 * wc + 8 * fq;
#pragma unroll
        for (int ai = 0; ai < 2; ++ai)
#pragma unroll
            for (int m = 0; m < 4; ++m) {
                bf16_t* rowp = O + ((size_t)u.pm * 256 + 128 * ai + 64 * wr + 16 * m + fr) * DM + col0;
                st8bf(rowp, acc[ai][0][m][0], acc[ai][0][m][1]); st8bf(rowp + 128, acc[ai][1][m][0], acc[ai][1][m][1]);
            }
    }
};
struct EpiGlaIn {
    bf16_t* Gq; bf16_t* Gk; bf16_t* Gv; bf16_t* Gr; float* Gz;
    __device__ __forceinline__ void operator()(const f32x4 (&acc)[2][2][4][2], const Unit& u, int wr, int wc, int fr, int fq) const {
        const int pn = u.pn;
        const size_t row0 = (size_t)u.pm * 256;
        if (pn == 12) {
            if (wc == 0) {
#pragma unroll
                for (int ai = 0; ai < 2; ++ai)
#pragma unroll
                    for (int m = 0; m < 4; ++m) {
                        float* rowp = Gz + (row0 + 128 * ai + 64 * wr + 16 * m + fr) * 32 + 8 * fq;
                        *(f32x4*)rowp = acc[ai][0][m][0]; *(f32x4*)(rowp + 4) = acc[ai][0][m][1];
                    }
            }
            return;
        }
        bf16_t* base; int ld, ct; float scl = 1.f;
        if (pn < 2) { base = Gq; ld = 512; ct = pn; scl = 0.08838834764831845f; }
        else if (pn < 4) { base = Gk; ld = 512; ct = pn - 2; }
        else if (pn < 8) { base = Gv; ld = 1024; ct = pn - 4; }
        else { base = Gr; ld = 1024; ct = pn - 8; }
        const int col0 = 256 * ct + 32 * wc + 8 * fq;
#pragma unroll
        for (int ai = 0; ai < 2; ++ai)
#pragma unroll
            for (int m = 0; m < 4; ++m) {
                bf16_t* rowp = base + (row0 + 128 * ai + 64 * wr + 16 * m + fr) * ld + col0;
                st8bf(rowp, acc[ai][0][m][0] * scl, acc[ai][0][m][1] * scl); st8bf(rowp + 128, acc[ai][1][m][0] * scl, acc[ai][1][m][1] * scl);
            }
    }
};
struct EpiGateUp {
    bf16_t* H; const float* bgu;
    __device__ __forceinline__ void operator()(const f32x4 (&acc)[2][2][4][2], const Unit& u, int wr, int wc, int fr, int fq) const {
        const int xc = 128 * u.pn + 32 * wc + 8 * fq;
        const float* bp = bgu + (size_t)u.e * 2048 + xc;
        const f32x4 bg0 = *(const f32x4*)bp, bg1 = *(const f32x4*)(bp + 4), bl0 = *(const f32x4*)(bp + 1024), bl1 = *(const f32x4*)(bp + 1028);
#pragma unroll
        for (int ai = 0; ai < 2; ++ai)
#pragma unroll
            for (int m = 0; m < 4; ++m) {
                f32x4 o0, o1;
#pragma unroll
                for (int i = 0; i < 4; ++i) {
                    float g = fminf(acc[ai][0][m][0][i] + bg0[i], 7.f), l = fminf(fmaxf(acc[ai][1][m][0][i] + bl0[i], -7.f), 7.f);
                    o0[i] = g * __builtin_amdgcn_rcpf(1.f + __expf(-1.702f * g)) * (l + 1.f);
                    g = fminf(acc[ai][0][m][1][i] + bg1[i], 7.f); l = fminf(fmaxf(acc[ai][1][m][1][i] + bl1[i], -7.f), 7.f);
                    o1[i] = g * __builtin_amdgcn_rcpf(1.f + __expf(-1.702f * g)) * (l + 1.f);
                }
                st8bf(H + ((size_t)u.pm * 256 + 128 * ai + 64 * wr + 16 * m + fr) * DM + xc, o0, o1);
            }
    }
};
struct EpiDown {
    bf16_t* YD; const float* bd;
    __device__ __forceinline__ void operator()(const f32x4 (&acc)[2][2][4][2], const Unit& u, int wr, int wc, int fr, int fq) const {
        const int col0 = 256 * u.pn + 32 * wc + 8 * fq;
        const float* bp = bd + (size_t)u.e * 1024 + col0;
        const f32x4 b00 = *(const f32x4*)bp, b01 = *(const f32x4*)(bp + 4), b10 = *(const f32x4*)(bp + 128), b11 = *(const f32x4*)(bp + 132);
#pragma unroll
        for (int ai = 0; ai < 2; ++ai)
#pragma unroll
            for (int m = 0; m < 4; ++m) {
                bf16_t* rowp = YD + ((size_t)u.pm * 256 + 128 * ai + 64 * wr + 16 * m + fr) * DM + col0;
                st8bf(rowp, acc[ai][0][m][0] + b00, acc[ai][0][m][1] + b01); st8bf(rowp + 128, acc[ai][1][m][0] + b10, acc[ai][1][m][1] + b11);
            }
    }
};
}

namespace att {
constexpr int NW = 8, QBLK = 32, KVBLK = 64;
constexpr size_t SHM_V = KVBLK * 128 * 2, SHM_K = KVBLK * 128 * 2;

constexpr float THR = 8.f;
#define KSWZ(row, colB) ((row) * 256 + ((colB) ^ (((row) & 7) << 4)))
__device__ __forceinline__ int v_st(int k, int c) { const int kk = (k & ~0xC) | ((k & 4) << 1) | ((k & 8) >> 1); return ((kk >> 3) * 4 + (c >> 5)) * 512 + ((kk & 7) * 32 + (c & 31)) * 2; }
__device__ __forceinline__ int v_rd_base(int lane) { return ((lane & 3) << 3) | (((lane >> 2) & 3) << 6) | (((lane >> 4) & 1) << 5) | (((lane >> 5) & 1) << 8); }
constexpr int v_rd_off(int d0, int ks, int half) { return d0 * 512 + ks * 4096 + half * 2048; }
template <int OFF> __device__ __forceinline__ s16x4 tr_read(int vb) {
    s16x4 r; asm volatile("ds_read_b64_tr_b16 %0, %1 offset:%2" : "=&v"(r) : "v"(vb), "i"(OFF) : "memory"); return r;
}
__device__ __forceinline__ void qkt_map(f32x16& p0, f32x16& p1, const char* Ks, const bf16x8* qs  , int mapB, int r32, int hi) {
    p0 = f32x16{}; p1 = f32x16{};
#pragma unroll
    for (int d0 = 0; d0 < 4; ++d0) { const int cb = mapB + (d0 * 16 + hi * 8) * 2;
        const bf16x8 b0 = *reinterpret_cast<const bf16x8*>(Ks + KSWZ(r32, cb));
        const bf16x8 b1 = *reinterpret_cast<const bf16x8*>(Ks + KSWZ(32 + r32, cb));
        const bf16x8 q = qs[d0 * 64];
        p0 = __builtin_amdgcn_mfma_f32_32x32x16_bf16(b0, q, p0, 0, 0, 0);
        p1 = __builtin_amdgcn_mfma_f32_32x32x16_bf16(b1, q, p1, 0, 0, 0); }
}
__device__ __forceinline__ void softmax_tile(f32x16& p0, f32x16& p1, float& m_reg, float& l_reg, float& alpha, bf16x8& pa0, bf16x8& pa1, bf16x8& pa2, bf16x8& pa3) {
    float pmax = p0[0];
#pragma unroll
    for (int r = 1; r < 16; ++r) pmax = fmaxf(pmax, p0[r]);
#pragma unroll
    for (int r = 0; r < 16; ++r) pmax = fmaxf(pmax, p1[r]);
    { auto rr = __builtin_amdgcn_permlane32_swap(__float_as_uint(pmax), __float_as_uint(pmax), false, false);
      pmax = fmaxf(__uint_as_float(rr[0]), __uint_as_float(rr[1])); }
    float mn;
    if (__builtin_expect(__all(pmax - m_reg <= THR), 1)) { mn = m_reg; alpha = 1.f; }
    else { mn = fmaxf(m_reg, pmax); alpha = __builtin_amdgcn_exp2f(m_reg - mn); m_reg = mn; }
#pragma unroll
    for (int r = 0; r < 16; ++r) p0[r] = __builtin_amdgcn_exp2f(p0[r] - mn);
#pragma unroll
    for (int r = 0; r < 16; ++r) p1[r] = __builtin_amdgcn_exp2f(p1[r] - mn);
    float ps = 0.f;
#pragma unroll
    for (int r = 0; r < 16; ++r) ps += p0[r];
#pragma unroll
    for (int r = 0; r < 16; ++r) ps += p1[r];
    { auto rr = __builtin_amdgcn_permlane32_swap(__float_as_uint(ps), __float_as_uint(ps), false, false);
      ps = __uint_as_float(rr[0]) + __uint_as_float(rr[1]); }
    l_reg = l_reg * alpha + ps;
#define PK4(P, BASE, OUT) do { unsigned a0 = cvt_pk_bf16(P[BASE + 0], P[BASE + 1]), a1 = cvt_pk_bf16(P[BASE + 2], P[BASE + 3]);   \
    unsigned b0 = cvt_pk_bf16(P[BASE + 4], P[BASE + 5]), b1 = cvt_pk_bf16(P[BASE + 6], P[BASE + 7]);                              \
    auto r0 = __builtin_amdgcn_permlane32_swap(a0, b0, false, false); auto r1 = __builtin_amdgcn_permlane32_swap(a1, b1, false, false); \
    u32x4 w = {r0[0], r1[0], r0[1], r1[1]}; OUT = *reinterpret_cast<bf16x8*>(&w); } while (0)
    PK4(p0, 0, pa0); PK4(p0, 8, pa1); PK4(p1, 0, pa2); PK4(p1, 8, pa3);
#undef PK4
}
template <int D0> __device__ __forceinline__ void pv_both(f32x16& oa, f32x16& ob, int vb, const bf16x8 (&pa)[4], const bf16x8 (&pb)[4]) {
    const s16x4 l0 = tr_read<v_rd_off(D0, 0, 0)>(vb), h0 = tr_read<v_rd_off(D0, 0, 1)>(vb), l1 = tr_read<v_rd_off(D0, 1, 0)>(vb), h1 = tr_read<v_rd_off(D0, 1, 1)>(vb);
    const s16x4 l2 = tr_read<v_rd_off(D0, 2, 0)>(vb), h2 = tr_read<v_rd_off(D0, 2, 1)>(vb), l3 = tr_read<v_rd_off(D0, 3, 0)>(vb), h3 = tr_read<v_rd_off(D0, 3, 1)>(vb);
    asm volatile("s_waitcnt lgkmcnt(0)" ::: "memory"); SBAR();
#define PK(L, H) (bf16x8){L[0], L[1], L[2], L[3], H[0], H[1], H[2], H[3]}
    const bf16x8 v0 = PK(l0, h0), v1 = PK(l1, h1), v2 = PK(l2, h2), v3 = PK(l3, h3);
    oa = __builtin_amdgcn_mfma_f32_32x32x16_bf16(pa[0], v0, oa, 0, 0, 0);
    ob = __builtin_amdgcn_mfma_f32_32x32x16_bf16(pb[0], v0, ob, 0, 0, 0);
    oa = __builtin_amdgcn_mfma_f32_32x32x16_bf16(pa[1], v1, oa, 0, 0, 0);
    ob = __builtin_amdgcn_mfma_f32_32x32x16_bf16(pb[1], v1, ob, 0, 0, 0);
    oa = __builtin_amdgcn_mfma_f32_32x32x16_bf16(pa[2], v2, oa, 0, 0, 0);
    ob = __builtin_amdgcn_mfma_f32_32x32x16_bf16(pb[2], v2, ob, 0, 0, 0);
    oa = __builtin_amdgcn_mfma_f32_32x32x16_bf16(pa[3], v3, oa, 0, 0, 0);
    ob = __builtin_amdgcn_mfma_f32_32x32x16_bf16(pb[3], v3, ob, 0, 0, 0);
#undef PK
}
__device__ __forceinline__ void attn_unit(const bf16_t* __restrict__ Qb, const bf16_t* __restrict__ Kh, const bf16_t* __restrict__ Vh, bf16_t* __restrict__ Ob,
                                          int nkeys, float lam, const float* __restrict__ subw, char* lds) {
    const int tid = threadIdx.x, wid = tid >> 6, lane = tid & 63, r32 = lane & 31, hi = lane >> 5;
    char* V_lds = lds; char* K_lds = lds + 2 * SHM_V;
    float* ws = (float*)(lds + LDS_MAIN + 256) + wid * 128;
    float m0 = -1e30f, l0 = 0.f, m1 = -1e30f, l1 = 0.f;
    f32x16 oa[4] = {}, ob[4] = {};
    bf16x8* qs = (bf16x8*)(lds + 2 * SHM_V + 2 * SHM_K + wid * 8192) + lane;
    { const bf16_t* Qw = Qb + (size_t)(wid * QBLK + r32) * DM + hi * 8;
#pragma unroll
      for (int d0 = 0; d0 < 8; ++d0) qs[d0 * 64] = *reinterpret_cast<const bf16x8*>(Qw + d0 * 16); }
    const int vb0 = (int)(uintptr_t)V_lds + v_rd_base(lane);
    LAS unsigned char* ldsK = (LAS unsigned char*)K_lds + wid * 1024; LAS unsigned char* ldsV = (LAS unsigned char*)V_lds + wid * 1024;
#define DMA_TILE(t, b) do { const char* kg = (const char*)Kh + (size_t)(t) * (KVBLK * DM * 2); const char* vg = (const char*)Vh + (size_t)(t) * (KVBLK * DM * 2); \
    int ln_ = lane; asm volatile("" : "+v"(ln_)); \
    _Pragma("unroll") for (int _i = 0; _i < 2; ++_i) { const int p_ = wid + 8 * _i; \
        const int krow_ = 4 * p_ + (ln_ >> 4), kch_ = (ln_ & 15) ^ (krow_ & 7); \
        const int within_ = ln_ & 31, kk_ = 8 * (p_ >> 1) + (within_ >> 2), k_ = (kk_ & ~0xC) | ((kk_ & 4) << 1) | ((kk_ & 8) >> 1), c_ = 32 * (2 * (p_ & 1) + (ln_ >> 5)) + 8 * (within_ & 3); \
        __builtin_amdgcn_global_load_lds((const unsigned*)(kg + (unsigned)(krow_ * DM + kch_ * 8) * 2u), (LAS unsigned*)(ldsK + (b) * SHM_K + _i * 8192), 16, 0, 0); \
        __builtin_amdgcn_global_load_lds((const unsigned*)(vg + (unsigned)(k_ * DM + c_) * 2u), (LAS unsigned*)(ldsV + (b) * SHM_V + _i * 8192), 16, 0, 0); } } while (0)
#define DMA_WAIT() asm volatile("s_waitcnt vmcnt(0)" ::: "memory")
#define RESC(o, a) do { if (__any((a) < 1.f)) { if (hi == 0) ws[r32] = (a); LDS_WAIT(); \
    _Pragma("unroll") for (int d = 0; d < 4; ++d) _Pragma("unroll") for (int r = 0; r < 16; ++r) o[d][r] *= ws[crow(r, hi)]; } } while (0)
    const int NT = nkeys / KVBLK;
    DMA_TILE(0, 0);
    DMA_WAIT();
    __syncthreads();
    for (int j = 0; j < NT; ++j) {
        const int b = j & 1;
        if (j + 1 < NT) DMA_TILE(j + 1, b ^ 1);
        const char* Kt = K_lds + b * SHM_K;
        f32x16 p0, p1; float al; bf16x8 pa[4], pb[4];
        qkt_map(p0, p1, Kt, qs, 0, r32, hi);
        softmax_tile(p0, p1, m0, l0, al, pa[0], pa[1], pa[2], pa[3]);
        RESC(oa, al);
        qkt_map(p0, p1, Kt, qs + 256, 128, r32, hi);
        softmax_tile(p0, p1, m1, l1, al, pb[0], pb[1], pb[2], pb[3]);
        RESC(ob, al);
        const int vb = vb0 + b * (int)SHM_V;
        pv_both<0>(oa[0], ob[0], vb, pa, pb); pv_both<1>(oa[1], ob[1], vb, pa, pb); pv_both<2>(oa[2], ob[2], vb, pa, pb); pv_both<3>(oa[3], ob[3], vb, pa, pb);
        DMA_WAIT();
        __syncthreads();
    }
    if (hi == 0) { ws[r32] = l0; ws[32 + r32] = l1; }
    LDS_WAIT();
    float ss[16];
#pragma unroll
    for (int r = 0; r < 16; ++r) { const float ra = __builtin_amdgcn_rcpf(ws[crow(r, hi)]), rb = lam * __builtin_amdgcn_rcpf(ws[32 + crow(r, hi)]);
        float s = 0.f;
#pragma unroll
        for (int d = 0; d < 4; ++d) { const float v = oa[d][r] * ra - ob[d][r] * rb; oa[d][r] = v; s += v * v; }
        ss[r] = s; }
#pragma unroll
    for (int r = 0; r < 16; ++r) {
#pragma unroll
        for (int o = 1; o < 32; o <<= 1) ss[r] += __shfl_xor(ss[r], o);
        ss[r] = rsqrtf(ss[r] * (1.f / 128.f) + NORM_EPS) * (1.f - LAM_INIT0);
    }
    float wv[4];
#pragma unroll
    for (int d = 0; d < 4; ++d) wv[d] = subw[d * 32 + r32];
    bf16_t* Ow = Ob + (size_t)(wid * QBLK) * DM;
#pragma unroll
    for (int r = 0; r < 16; ++r) { const int orow = crow(r, hi);
#pragma unroll
        for (int d = 0; d < 4; ++d) Ow[(size_t)orow * DM + d * 32 + r32] = (bf16_t)(cvt_pk_bf16(oa[d][r] * ss[r] * wv[d], 0.f) & 0xffffu); }
    __syncthreads();
#undef DMA_TILE
#undef DMA_WAIT
#undef RESC
}
}

struct Args { const float* in[23]; float* out; unsigned char* ws; int ph_lo, ph_hi; };

enum { I_X = 0, I_C, I_CTX, I_CCTX, I_ADAW, I_ADAB, I_LNG, I_LNB, I_DAWIN, I_DAWOUT, I_DALAM, I_DASUBLN, I_GWIN, I_GWGATE, I_GBGATE, I_GNORM, I_GWOUT,
       I_RW, I_RB, I_WGU, I_BGU, I_WD, I_BD };

__device__ __forceinline__ void transpose_item(const float* W, int N, bf16_t* WT, int k0, int n0, int drow0, float* scr, int lane) {
#pragma unroll 8
    for (int i = 0; i < 32; ++i) { const int kk = 2 * i + (lane >> 5); scr[kk * 33 + (lane & 31)] = W[(size_t)(k0 + kk) * N + n0 + (lane & 31)]; }
    LDS_WAIT(); asm volatile("" ::: "memory");
    const int c = lane & 7;
#pragma unroll
    for (int j = 0; j < 4; ++j) { const int n = (lane >> 3) + 8 * j; const float* s = scr + (8 * c) * 33 + n;
        u32x4 o; o.x = cvt_pk_bf16(s[0 * 33], s[1 * 33]); o.y = cvt_pk_bf16(s[2 * 33], s[3 * 33]); o.z = cvt_pk_bf16(s[4 * 33], s[5 * 33]); o.w = cvt_pk_bf16(s[6 * 33], s[7 * 33]);
        *(u32x4*)(WT + (size_t)(drow0 + n) * 1024 + k0 + 8 * c) = o; }
    LDS_WAIT(); asm volatile("" ::: "memory");
}
__device__ __forceinline__ int map_qkv(int n0) {
    if (n0 >= 2048) return n0;
    const int sec = n0 >> 10, nn = n0 & 1023, blk = nn >> 6, half = (nn >> 5) & 1;
    return sec * 1024 + 256 * (blk >> 2) + 128 * half + 32 * (blk & 3);
}
__device__ __forceinline__ int map_gu(int n0) {
    const int half = n0 >> 10, nn = n0 & 1023;
    return 256 * (nn >> 7) + 128 * half + (nn & 127);
}

#ifndef PH_MASK
#define PH_MASK 0xFFFFFu
#endif
#define IN(k) (((PH_MASK >> (k)) & 1u) && lo <= (k) && (k) < hi_ph)
#define SEAM(k) do { if (IN(k) && IN((k) + 1)) xcd_barrier(bar); } while (0)
#define MOD ((float*)(ws + WS_MOD))
#define ROPE ((float*)(ws + WS_ROPE))
#define HIST ((int*)(ws + WS_HIST))
#define BLKEXP ((int*)(ws + WS_BLKEXP))
#define TOKE ((int*)(ws + WS_TOKE))
#define TOKG ((float*)(ws + WS_TOKG))
#define TOKR ((int*)(ws + WS_TOKR))
#define GZ ((float*)(ws + WS_GZ))
#define DEC ((float*)(ws + WS_DEC))
#define WQKV ((bf16_t*)(ws + WS_WQKV))
#define WO ((bf16_t*)(ws + WS_WO))
#define WGIN ((bf16_t*)(ws + WS_WGIN))
#define WGOUT ((bf16_t*)(ws + WS_WGOUT))
#define WGU ((bf16_t*)(ws + WS_WGU))
#define WD ((bf16_t*)(ws + WS_WD))
#define TB ((bf16_t*)(ws + WS_T))
#define QB ((bf16_t*)(ws + WS_Q))
#define KC ((bf16_t*)(ws + WS_KC))
#define VC ((bf16_t*)(ws + WS_VC))
#define AO ((bf16_t*)(ws + WS_AO))
#define YB ((bf16_t*)(ws + WS_Y))
#define UB ((bf16_t*)(ws + WS_U))
#define X1 ((float*)(ws + WS_X1))
#define X2 ((float*)(ws + WS_X2))
#define XS ((bf16_t*)(ws + WS_XS))
#define HB ((bf16_t*)(ws + WS_H))
#define YD XS
#define GQ QB
#define GK (QB + (size_t)T0 * 512)
#define GV KC
#define GR VC
#define DS HB

__device__ __forceinline__ const float* inptr(const unsigned char* lds, int i) {
    const u32x2 v = *(const u32x2*)(lds + LDS_MISC + 64 + 8 * i);
    const unsigned long long p = ((unsigned long long)(unsigned)__builtin_amdgcn_readfirstlane((int)v.y) << 32) | (unsigned)__builtin_amdgcn_readfirstlane((int)v.x);
    return (const float*)p;
}
#define INP(i) inptr(lds, (i))

template <int L>
__device__ __forceinline__ void moe_layer(unsigned char* ws, unsigned char* lds, const XcdBarrier& bar, const int lo, const int hi_ph) {
    const int tid = threadIdx.x, lane = tid & 63, wave = __builtin_amdgcn_readfirstlane(tid >> 6);
    const int G = gridDim.x, blk = blockIdx.x;
    constexpr int NT = L == 0 ? T0 : TLAT;
    constexpr int pb = L == 0 ? 5 : 15;
    const float* modl = MOD + (size_t)L * 5 * 6144;
    const int per = NT / G;
    if (IN(pb)) {
        float* UROW = (float*)lds;
        float* PART = (float*)lds + 16 * 1024;
        int* HL = (int*)(lds + 98304);
        const float* lng = INP(I_LNG) + (size_t)(L * 2 + 0) * DM; const float* lnb = INP(I_LNB) + (size_t)(L * 2 + 0) * DM;
        const float* rw = INP(I_RW) + (size_t)L * DM * NEXP; const float* rb = INP(I_RB) + L * NEXP;
        const int e = lane & 31, hh = lane >> 5;
        float wreg[64];
#pragma unroll
        for (int i = 0; i < 64; ++i) wreg[i] = rw[(size_t)(128 * wave + 64 * hh + i) * NEXP + e];
        if (tid < 32) HL[tid] = 0;
        __syncthreads();
        const int t0 = blk * per;
        for (int bt = 0; bt < per; bt += 16) {
#pragma unroll 1
            for (int q = 0; q < 2; ++q) { const int rr = 2 * wave + q, r = t0 + bt + rr;
                if (bt + rr < per) {
                    const int mrow = r < TLAT ? (r >> 13) : 4;
                    const float* xin = L == 0 ? (r < TLAT ? INP(I_X) + (size_t)r * DM : INP(I_CTX) + (size_t)(r - TLAT) * DM) : X2 + (size_t)r * DM;
                    const float* mod = modl + (size_t)mrow * 6144;
                    f32x4 v[4]; float s = 0.f;
#pragma unroll
                    for (int j = 0; j < 4; ++j) { const int idx = 4 * lane + 256 * j; const f32x4 xv = *(const f32x4*)(xin + idx), g1 = *(const f32x4*)(mod + 2048 + idx);
                        const u32x2 yy = *(const u32x2*)(YB + (size_t)r * DM + idx);
                        v[j][0] = ALPHA * xv[0] + g1[0] * bflo(yy.x); v[j][1] = ALPHA * xv[1] + g1[1] * bfhi(yy.x); v[j][2] = ALPHA * xv[2] + g1[2] * bflo(yy.y); v[j][3] = ALPHA * xv[3] + g1[3] * bfhi(yy.y);
                        s += (v[j][0] + v[j][1]) + (v[j][2] + v[j][3]); }
                    const float mean = wave_sum(s) * (1.f / DM); float s2 = 0.f;
#pragma unroll
                    for (int j = 0; j < 4; ++j) { v[j] = v[j] - mean; s2 += (v[j][0] * v[j][0] + v[j][1] * v[j][1]) + (v[j][2] * v[j][2] + v[j][3] * v[j][3]); }
                    const float rstd = rsqrtf(wave_sum(s2) * (1.f / DM) + NORM_EPS);
#pragma unroll
                    for (int j = 0; j < 4; ++j) { const int idx = 4 * lane + 256 * j; const f32x4 gg = *(const f32x4*)(lng + idx), bb = *(const f32x4*)(lnb + idx);
                        const f32x4 sh = *(const f32x4*)(mod + 3072 + idx), sc = *(const f32x4*)(mod + 4096 + idx);
                        f32x4 x1 = v[j] * rstd * gg + bb;
                        *(f32x4*)(X1 + (size_t)r * DM + idx) = x1;
                        f32x4 u = x1 * (1.f + sc) + sh;
                        *(f32x4*)(UROW + rr * 1024 + idx) = u;
                        u32x2 o; o.x = cvt_pk_bf16(u[0], u[1]); o.y = cvt_pk_bf16(u[2], u[3]);
                        *(u32x2*)(UB + (size_t)r * DM + idx) = o; }
                }
            }
            __syncthreads();
#pragma unroll 1
            for (int rr = 0; rr < 16; ++rr) { const float* up = UROW + rr * 1024 + 128 * wave + 64 * hh; float a = 0.f;
#pragma unroll
                for (int i = 0; i < 16; ++i) { const f32x4 uv = *(const f32x4*)(up + 4 * i); a += uv[0] * wreg[4 * i] + uv[1] * wreg[4 * i + 1] + uv[2] * wreg[4 * i + 2] + uv[3] * wreg[4 * i + 3]; }
                a += __shfl_xor(a, 32);
                if (hh == 0) PART[(wave * 16 + rr) * 32 + e] = a; }
            __syncthreads();
            { const int rr = 2 * wave + hh, r = t0 + bt + rr;
              float lg = rb[e];
#pragma unroll
              for (int w = 0; w < 8; ++w) lg += PART[(w * 16 + rr) * 32 + e];
              float tv[4]; int ti[4];
#pragma unroll
              for (int t = 0; t < 4; ++t) { float mx = lg;
#pragma unroll
                  for (int o = 1; o < 32; o <<= 1) mx = fmaxf(mx, __shfl_xor(mx, o));
                  int cand = (lg == mx) ? e : 99;
#pragma unroll
                  for (int o = 1; o < 32; o <<= 1) cand = min(cand, __shfl_xor(cand, o));
                  cand = cand > 31 ? t : cand;
                  tv[t] = mx; ti[t] = cand; if (e == cand) lg = -__builtin_inff(); }
              if (bt + rr < per && e == 0) {
                  const float e1 = __expf(tv[1] - tv[0]), e2 = __expf(tv[2] - tv[0]), e3 = __expf(tv[3] - tv[0]); const float inv = 1.f / (1.f + e1 + e2 + e3);
                  *(f32x4*)(TOKG + (size_t)r * 4) = (f32x4){inv, e1 * inv, e2 * inv, e3 * inv};
                  int* te = TOKE + (size_t)r * 4; te[0] = ti[0]; te[1] = ti[1]; te[2] = ti[2]; te[3] = ti[3];
                  atomicAdd(&HL[ti[0]], 1); atomicAdd(&HL[ti[1]], 1); atomicAdd(&HL[ti[2]], 1); atomicAdd(&HL[ti[3]], 1); } }
            __syncthreads();
        }
        if (tid < 32) HIST[blk * 32 + tid] = HL[tid];
    }
    SEAM(pb);

    if (IN(pb + 1)) {
        int* SA = (int*)lds; int* SB_ = SA + 512; int* PS = SB_ + 512; int* BASE = PS + 64; int* EL = BASE + 32; int* RL = EL + 1024;
        { const int e = tid & 31, part = tid >> 5; int sa = 0, sb = 0;
          for (int bb = part; bb < G; bb += 16) { const int hv = HIST[bb * 32 + e]; sa += hv; if (bb < blk) sb += hv; }
          SA[part * 32 + e] = sa; SB_[part * 32 + e] = sb; }
        __syncthreads();
        if (tid < 32) { int tot = 0, bef = 0;
            for (int p = 0; p < 16; ++p) { tot += SA[p * 32 + tid]; bef += SB_[p * 32 + tid]; }
            const int padded = (tot + 255) & ~255;
            int incl = padded;
#pragma unroll
            for (int o = 1; o < 32; o <<= 1) { const int t = __shfl_up(incl, o); if (tid >= o) incl += t; }
            const int pstart = incl - padded;
            PS[tid] = pstart; BASE[tid] = pstart + bef;
            if (blk == 0) { for (int rbk = pstart >> 8; rbk < (incl >> 8); ++rbk) BLKEXP[rbk] = tid; if (tid == 31) BLKEXP[1023] = incl >> 8; } }
        const int t0 = blk * per, na = per * 4;
        for (int i = tid; i < na; i += 512) EL[i] = TOKE[(size_t)t0 * 4 + i];
        __syncthreads();
        if (tid < 32) { int cnt = BASE[tid];
            for (int i = 0; i < na; ++i) if (EL[i] == tid) { RL[i] = cnt; ++cnt; } }
        __syncthreads();
        for (int i = tid; i < na; i += 512) TOKR[(size_t)t0 * 4 + i] = RL[i];
        for (int i = wave; i < na; i += 8) { const size_t tok = (size_t)t0 + (i >> 2); const size_t dst = (size_t)RL[i];
            const u32x4* sp = (const u32x4*)(UB + tok * DM); u32x4* dp = (u32x4*)(XS + dst * DM);
            dp[lane] = sp[lane]; dp[64 + lane] = sp[64 + lane]; }
    }
    SEAM(pb + 1);

    if (IN(pb + 2)) {
        const int nblk = __builtin_amdgcn_readfirstlane(BLKEXP[1023]);
        pg8::MoeOrder S; S.init(XS, WGU + (size_t)L * 32 * 2048 * 1024, BLKEXP, nblk, 8, G, blk);
        pg8::EpiGateUp E{HB, INP(I_BGU) + (size_t)L * 32 * 2048};
        pg8::gemm_phase<pg8::EpiGateUp, pg8::MoeOrder, true, true>((LAS unsigned char*)lds, S, E);
    }
    SEAM(pb + 2);

    if (IN(pb + 3)) {
        const int nblk = __builtin_amdgcn_readfirstlane(BLKEXP[1023]);
        pg8::MoeOrder S; S.init(HB, WD + (size_t)L * 32 * 1024 * 1024, BLKEXP, nblk, 4, G, blk);
        pg8::EpiDown E{YD, INP(I_BD) + (size_t)L * 32 * 1024};
        pg8::gemm_phase<pg8::EpiDown, pg8::MoeOrder, true, true>((LAS unsigned char*)lds, S, E);
    }
    SEAM(pb + 3);

    if (IN(pb + 4)) {
        const float* lng = INP(I_LNG) + (size_t)(L * 2 + 1) * DM; const float* lnb = INP(I_LNB) + (size_t)(L * 2 + 1) * DM;
        for (int r = blk * 8 + wave; r < NT; r += G * 8) {
            const int mrow = r < TLAT ? (r >> 13) : 4;
            const float* mod = modl + (size_t)mrow * 6144;
            const f32x4 gt = *(const f32x4*)(TOKG + (size_t)r * 4);
            const int* tr = TOKR + (size_t)r * 4; const size_t r0 = tr[0], r1 = tr[1], r2 = tr[2], r3 = tr[3];
            f32x4 v[4]; float s = 0.f;
#pragma unroll
            for (int j = 0; j < 4; ++j) { const int idx = 4 * lane + 256 * j;
                const u32x2 y0 = *(const u32x2*)(YD + r0 * DM + idx), y1 = *(const u32x2*)(YD + r1 * DM + idx), y2 = *(const u32x2*)(YD + r2 * DM + idx), y3 = *(const u32x2*)(YD + r3 * DM + idx);
                const f32x4 xv = *(const f32x4*)(X1 + (size_t)r * DM + idx), g2 = *(const f32x4*)(mod + 5120 + idx);
                f32x4 f;
                f[0] = gt[0] * bflo(y0.x) + gt[1] * bflo(y1.x) + gt[2] * bflo(y2.x) + gt[3] * bflo(y3.x);
                f[1] = gt[0] * bfhi(y0.x) + gt[1] * bfhi(y1.x) + gt[2] * bfhi(y2.x) + gt[3] * bfhi(y3.x);
                f[2] = gt[0] * bflo(y0.y) + gt[1] * bflo(y1.y) + gt[2] * bflo(y2.y) + gt[3] * bflo(y3.y);
                f[3] = gt[0] * bfhi(y0.y) + gt[1] * bfhi(y1.y) + gt[2] * bfhi(y2.y) + gt[3] * bfhi(y3.y);
                v[j] = ALPHA * xv + g2 * f;
                s += (v[j][0] + v[j][1]) + (v[j][2] + v[j][3]); }
            const float mean = wave_sum(s) * (1.f / DM); float s2 = 0.f;
#pragma unroll
            for (int j = 0; j < 4; ++j) { v[j] = v[j] - mean; s2 += (v[j][0] * v[j][0] + v[j][1] * v[j][1]) + (v[j][2] * v[j][2] + v[j][3] * v[j][3]); }
            const float rstd = rsqrtf(wave_sum(s2) * (1.f / DM) + NORM_EPS);
#pragma unroll
            for (int j = 0; j < 4; ++j) { const int idx = 4 * lane + 256 * j; const f32x4 gg = *(const f32x4*)(lng + idx), bb = *(const f32x4*)(lnb + idx);
                const f32x4 x2 = v[j] * rstd * gg + bb;
                if (L == 0) {
                    *(f32x4*)(X2 + (size_t)r * DM + idx) = x2;
                    const float* mod1 = MOD + (size_t)(5 + mrow) * 6144;
                    const f32x4 sh = *(const f32x4*)(mod1 + idx), sc = *(const f32x4*)(mod1 + 1024 + idx);
                    const f32x4 t = x2 * (1.f + sc) + sh;
                    u32x2 o; o.x = cvt_pk_bf16(t[0], t[1]); o.y = cvt_pk_bf16(t[2], t[3]);
                    *(u32x2*)(TB + (size_t)r * DM + idx) = o;
                } else *(f32x4*)((float*)INP(23) + (size_t)r * DM + idx) = x2; }
        }
    }
    if (L == 0) SEAM(pb + 4);
}

__global__ void __launch_bounds__(512, 2) fwd_kernel(Args args) {
    extern __shared__ __attribute__((aligned(16))) unsigned char lds[];
    const int tid = threadIdx.x, lane = tid & 63, wave = __builtin_amdgcn_readfirstlane(tid >> 6);
    const int G = gridDim.x, blk = blockIdx.x;
    unsigned char* ws = args.ws;
    const int lo = args.ph_lo, hi_ph = args.ph_hi;

    volatile LAS unsigned* misc = (volatile LAS unsigned*)((LAS unsigned char*)lds + LDS_MISC);
    if (tid < 4) misc[tid] = 0u;
    if (tid < 24) { const unsigned long long p = tid < 23 ? (unsigned long long)args.in[tid] : (unsigned long long)args.out; *(unsigned long long*)(lds + LDS_MISC + 64 + 8 * tid) = p; }
    __syncthreads();
    XcdBarrier bar; bar.bar = (unsigned*)(ws + WS_CTL); bar.x = 0; bar.st = misc;
    if (hi_ph - lo > 1) bar = xcd_barrier_post((unsigned*)(ws + WS_CTL), misc);


    if (IN(0)) {
        float* S = (float*)lds;
        float* PART = (float*)lds + 5 * 1024;
        for (int i = tid; i < 5 * 1024; i += 512) { const int r = i >> 10, k = i & 1023; const float v = r < 4 ? INP(I_C)[r * 1024 + k] : INP(I_CCTX)[k]; S[i] = siluf(v); }
        __syncthreads();
        for (int item = blk; item < 192; item += G) {
            const int l = item / 96, n = (item % 96) * 64 + lane;
            const float* wp = INP(I_ADAW) + (size_t)l * 1024 * 6144 + n;
            float a0 = 0.f, a1 = 0.f, a2 = 0.f, a3 = 0.f, a4 = 0.f;
#pragma unroll 8
            for (int kk = 0; kk < 128; ++kk) { const int k = wave * 128 + kk; const float w = wp[(size_t)k * 6144];
                a0 += S[k] * w; a1 += S[1024 + k] * w; a2 += S[2048 + k] * w; a3 += S[3072 + k] * w; a4 += S[4096 + k] * w; }
            float* pp = PART + wave * 320 + lane;
            pp[0] = a0; pp[64] = a1; pp[128] = a2; pp[192] = a3; pp[256] = a4;
            __syncthreads();
            if (tid < 320) { const int r = tid >> 6, ln = tid & 63; float s = 0.f;
#pragma unroll
                for (int w = 0; w < 8; ++w) s += PART[w * 320 + r * 64 + ln];
                const int nn = (item % 96) * 64 + ln;
                MOD[((size_t)l * 5 + r) * 6144 + nn] = s + INP(I_ADAB)[l * 6144 + nn]; }
            __syncthreads();
        }
        if (blk == G - 1) for (int i = tid; i < 2048; i += 512) { const int v = i >> 4, jj = i & 15; const float inv = powf(10000.f, -(float)jj / 16.f); const float ang = (float)v * inv;
            ROPE[2 * i] = cosf(ang); ROPE[2 * i + 1] = sinf(ang); }
        for (int i = blk * 512 + tid; i < (GIN_NP - GIN_N) * 1024 / 8; i += G * 512) ((u32x4*)(WGIN + (size_t)GIN_N * 1024))[i] = (u32x4){0u, 0u, 0u, 0u};
        __syncthreads();
        float* scr = (float*)lds + wave * (64 * 33);
        const int gw = blk * 8 + wave, NGW = G * 8;
        constexpr int I_A = 16 * 96, I_B = 16 * 32, I_C2 = 16 * 97, I_D = 16 * 32, I_SMALL = I_A + I_B + I_C2 + I_D, I_GUx = 64 * 16 * 64, I_DNx = 64 * 16 * 32;
        for (int it = gw; it < I_SMALL + I_GUx + I_DNx; it += NGW) {
            int r = it;
            if (r < I_A) { const int kb = r / 96, nb = r % 96; transpose_item(INP(I_DAWIN), 3072, WQKV, 64 * kb, 32 * nb, map_qkv(32 * nb), scr, lane); continue; } r -= I_A;
            if (r < I_B) { const int kb = r / 32, nb = r % 32; transpose_item(INP(I_DAWOUT), 1024, WO, 64 * kb, 32 * nb, 32 * nb, scr, lane); continue; } r -= I_B;
            if (r < I_C2) { const int kb = r / 97, nb = r % 97; transpose_item(INP(I_GWIN), GIN_N, WGIN, 64 * kb, 32 * nb, 32 * nb, scr, lane); continue; } r -= I_C2;
            if (r < I_D) { const int kb = r / 32, nb = r % 32; transpose_item(INP(I_GWOUT), 1024, WGOUT, 64 * kb, 32 * nb, 32 * nb, scr, lane); continue; } r -= I_D;
            if (r < I_GUx) { const int mat = r >> 10, q = r & 1023, kb = q >> 6, nb = q & 63;
                transpose_item(INP(I_WGU) + (size_t)mat * 1024 * 2048, 2048, WGU + (size_t)mat * 2048 * 1024, 64 * kb, 32 * nb, map_gu(32 * nb), scr, lane); continue; } r -= I_GUx;
            { const int mat = r >> 9, q = r & 511, kb = q >> 5, nb = q & 31;
                transpose_item(INP(I_WD) + (size_t)mat * 1024 * 1024, 1024, WD + (size_t)mat * 1024 * 1024, 64 * kb, 32 * nb, 32 * nb, scr, lane); }
        }
    }
    SEAM(0);

    if (IN(1)) {
        for (int r = blk * 8 + wave; r < T0; r += G * 8) {
            const float* src = r < TLAT ? INP(I_X) + (size_t)r * DM : INP(I_CTX) + (size_t)(r - TLAT) * DM;
            const float* mod = MOD + (size_t)(r < TLAT ? (r >> 13) : 4) * 6144;
#pragma unroll
            for (int j = 0; j < 4; ++j) { const int idx = 4 * lane + 256 * j;
                const f32x4 v = *(const f32x4*)(src + idx), sh = *(const f32x4*)(mod + idx), sc = *(const f32x4*)(mod + 1024 + idx);
                u32x2 o; o.x = cvt_pk_bf16(v[0] * (1.f + sc[0]) + sh[0], v[1] * (1.f + sc[1]) + sh[1]); o.y = cvt_pk_bf16(v[2] * (1.f + sc[2]) + sh[2], v[3] * (1.f + sc[3]) + sh[3]);
                *(u32x2*)(TB + (size_t)r * DM + idx) = o; }
        }
    }
    SEAM(1);

    if (IN(2)) {
        pg8::DenseOrder S; S.init(TB, WQKV, T0, 3072, G, blk);
        pg8::EpiQKV E{QB, KC, VC, ROPE};
        pg8::gemm_phase<pg8::EpiQKV, pg8::DenseOrder, true, true>((LAS unsigned char*)lds, S, E);
    }
    SEAM(2);

    if (IN(3)) {
        const float* lv = INP(I_DALAM);
        const float s1 = wave_sum(lv[lane] * lv[64 + lane]), s2 = wave_sum(lv[128 + lane] * lv[192 + lane]);
        const float lam = expf(s1) - expf(s2) + LAM_INIT0;
        for (int i = 0;; ++i) {
            const int L = i * G + blk;
            if (L >= 1024 + 32) break;
            if (L < 1024) {
                int bh, qb;
                if (G == 256) { bh = i * 8 + (blk & 7); qb = blk >> 3; }
                else { bh = L >> 5; qb = L & 31; }
                const int b = bh >> 3, h = bh & 7;
                att::attn_unit(QB + ((size_t)b * SEQ + qb * 256) * DM + h * 128, KC + (size_t)b * KVLEN * DM + h * 128, VC + (size_t)b * KVLEN * DM + h * 128,
                               AO + ((size_t)b * SEQ + qb * 256) * DM + h * 128, KVLEN, lam, INP(I_DASUBLN), (char*)lds);
            } else {
                const int bh = L - 1024, b = bh >> 3, h = bh & 7;
                att::attn_unit(QB + ((size_t)TLAT + b * NCTX) * DM + h * 128, KC + (size_t)b * KVLEN * DM + h * 128, VC + (size_t)b * KVLEN * DM + h * 128,
                               AO + ((size_t)TLAT + b * NCTX) * DM + h * 128, NCTX, lam, INP(I_DASUBLN), (char*)lds);
            }
        }
    }
    SEAM(3);

    if (IN(4)) {
        pg8::DenseOrder S; S.init(AO, WO, T0, 1024, G, blk);
        pg8::EpiPlain E{YB};
        pg8::gemm_phase<pg8::EpiPlain, pg8::DenseOrder, true, true>((LAS unsigned char*)lds, S, E);
    }
    SEAM(4);

    moe_layer<0>(ws, lds, bar, lo, hi_ph);

    {
    if (IN(10)) {
        pg8::DenseOrder S; S.init(TB, WGIN, T0, GIN_NP, G, blk);
        pg8::EpiGlaIn E{GQ, GK, GV, GR, GZ};
        pg8::gemm_phase<pg8::EpiGlaIn, pg8::DenseOrder, true, true>((LAS unsigned char*)lds, S, E);
    }
    SEAM(10);

    bf16_t* VT = (bf16_t*)lds;
    float* ZL = (float*)(lds + 36864);
    float* TOT = (float*)(lds + 45056);
    bf16_t* QIN = (bf16_t*)(lds + 47104);
    bf16_t* KIN = (bf16_t*)(lds + 64512);
    bf16_t* ATT = (bf16_t*)(lds + 81920);
    float* OL = (float*)lds;
    const int r32 = lane & 31, hi = lane >> 5;
    const float* wg = INP(I_GWGATE); const float* bgt = INP(I_GBGATE);

    if (IN(11)) {
        bf16_t* KST = QIN;
        for (int it = blk; it < 16 * NPC; it += G) {
            const int bh = it / NPC, pc = it % NPC, b = bh >> 2, h = bh & 3;
            const size_t rowb = pc < 4 ? (size_t)TLAT + b * NCTX + 64 * pc : (size_t)b * SEQ + 64 * (pc - 4);
            { const int e = tid & 255, ch = tid >> 8;
#pragma unroll
              for (int q = 0; q < 4; ++q) { unsigned w[4];
#pragma unroll
                  for (int p = 0; p < 4; ++p) { const int c = 32 * ch + 8 * q + 2 * p;
                      const unsigned lo16 = GV[(rowb + c) * 1024 + h * 256 + e], hi16 = GV[(rowb + c + 1) * 1024 + h * 256 + e]; w[p] = lo16 | (hi16 << 16); }
                  *(u32x4*)(VT + e * 72 + 32 * ch + 8 * q) = (u32x4){w[0], w[1], w[2], w[3]}; }
              for (int i = tid; i < 2048; i += 512) ZL[i] = GZ[rowb * 32 + i]; }
            __syncthreads();
#pragma unroll 1
            for (int dir = 0; dir < 2; ++dir) {
                const int d = tid & 127, cg = tid >> 7;
                float g[16];
                { float wv[16];
#pragma unroll
                  for (int r = 0; r < 16; ++r) wv[r] = wg[(size_t)(dir * 16 + r) * 512 + h * 128 + d];
                  const float bias = bgt[dir * 512 + h * 128 + d];
#pragma unroll
                  for (int i = 0; i < 16; ++i) { const float* z = ZL + (16 * cg + i) * 32 + dir * 16; float xg = bias;
#pragma unroll
                      for (int r = 0; r < 16; ++r) xg += z[r] * wv[r];
                      g[i] = logsigf(xg) * (1.f / 16.f); } }
                if (dir == 0) { for (int i = 1; i < 16; ++i) g[i] += g[i - 1]; TOT[cg * 128 + d] = g[15]; }
                else { for (int i = 14; i >= 0; --i) g[i] += g[i + 1]; TOT[cg * 128 + d] = g[0]; }
                __syncthreads();
                float pre = 0.f, ball = 0.f;
#pragma unroll
                for (int q = 0; q < 4; ++q) { const float t = TOT[q * 128 + d]; ball += t; if (dir == 0 ? (q < cg) : (q > cg)) pre += t; }
                unsigned w[8];
#pragma unroll
                for (int p = 0; p < 8; ++p) { const int c = 16 * cg + 2 * p;
                    const float k0 = bf2f(GK[(rowb + c) * 512 + h * 128 + d]), k1 = bf2f(GK[(rowb + c + 1) * 512 + h * 128 + d]);
                    w[p] = cvt_pk_bf16(k0 * __expf(ball - (g[2 * p] + pre)), k1 * __expf(ball - (g[2 * p + 1] + pre))); }
                *(u32x4*)(KST + d * 72 + 16 * cg) = (u32x4){w[0], w[1], w[2], w[3]};
                *(u32x4*)(KST + d * 72 + 16 * cg + 8) = (u32x4){w[4], w[5], w[6], w[7]};
                const int seq = bh * 2 + dir;
                if (cg == 0) DEC[((size_t)seq * NPC + pc) * 128 + d] = __expf(ball);
                __syncthreads();
                f32x16 acc[4] = {};
#pragma unroll
                for (int ks = 0; ks < 4; ++ks) { const bf16x8 a = *(const bf16x8*)(VT + (32 * wave + r32) * 72 + 16 * ks + 8 * hi);
#pragma unroll
                    for (int nb = 0; nb < 4; ++nb) { const bf16x8 bb = *(const bf16x8*)(KST + (32 * nb + r32) * 72 + 16 * ks + 8 * hi);
                        acc[nb] = __builtin_amdgcn_mfma_f32_32x32x16_bf16(a, bb, acc[nb], 0, 0, 0); } }
                bf16_t* dsp = DS + (((size_t)seq * NPC + pc) * 256 + 32 * wave) * 128;
#pragma unroll
                for (int nb = 0; nb < 4; ++nb)
#pragma unroll
                    for (int r = 0; r < 16; ++r) dsp[(size_t)crow(r, hi) * 128 + 32 * nb + r32] = (bf16_t)(cvt_pk_bf16(acc[nb][r], 0.f) & 0xffffu);
                __syncthreads();
            }
        }
    }
    SEAM(11);

    if (IN(12)) {
        for (int gid = blk * 512 + tid; gid < 32 * 4096; gid += G * 512) {
            const int seq = gid >> 12, rem = gid & 4095, e = rem >> 4, dg = rem & 15, dir = seq & 1;
            bf16_t* base = DS + ((size_t)seq * NPC * 256 + e) * 128 + 8 * dg;
            const float* dbase = DEC + (size_t)seq * NPC * 128 + 8 * dg;
            float s[8];
#pragma unroll
            for (int i = 0; i < 8; ++i) s[i] = 0.f;
            for (int st0 = 0; st0 < NPC; st0 += 4) {
                u32x4 dv[4]; f32x4 da[4], db[4]; int pcs[4];
#pragma unroll
                for (int u = 0; u < 4; ++u) { const int st = st0 + u; const int pc = dir == 0 ? st : (st < 4 ? 3 - st : 135 - st); pcs[u] = pc;
                    dv[u] = *(const u32x4*)(base + (size_t)pc * 256 * 128); da[u] = *(const f32x4*)(dbase + pc * 128); db[u] = *(const f32x4*)(dbase + pc * 128 + 4); }
#pragma unroll
                for (int u = 0; u < 4; ++u) {
                    if (pcs[u] >= 4) { u32x4 o; o.x = cvt_pk_bf16(s[0], s[1]); o.y = cvt_pk_bf16(s[2], s[3]); o.z = cvt_pk_bf16(s[4], s[5]); o.w = cvt_pk_bf16(s[6], s[7]);
                        *(u32x4*)(base + (size_t)pcs[u] * 256 * 128) = o; }
                    s[0] = da[u][0] * s[0] + bflo(dv[u].x); s[1] = da[u][1] * s[1] + bfhi(dv[u].x); s[2] = da[u][2] * s[2] + bflo(dv[u].y); s[3] = da[u][3] * s[3] + bfhi(dv[u].y);
                    s[4] = db[u][0] * s[4] + bflo(dv[u].z); s[5] = db[u][1] * s[5] + bfhi(dv[u].z); s[6] = db[u][2] * s[6] + bflo(dv[u].w); s[7] = db[u][3] * s[7] + bfhi(dv[u].w);
                }
            }
        }
    }
    SEAM(12);

    if (IN(13)) {
        for (int it = blk; it < 16 * 128; it += G) {
            const int bh = it >> 7, n = it & 127, pc = n + 4, b = bh >> 2, h = bh & 3;
            const size_t rowb = (size_t)b * SEQ + 64 * n;
            { const int e = tid & 255, ch = tid >> 8;
#pragma unroll
              for (int q = 0; q < 4; ++q) { unsigned w[4];
#pragma unroll
                  for (int p = 0; p < 4; ++p) { const int c = 32 * ch + 8 * q + 2 * p;
                      const unsigned lo16 = GV[(rowb + c) * 1024 + h * 256 + e], hi16 = GV[(rowb + c + 1) * 1024 + h * 256 + e]; w[p] = lo16 | (hi16 << 16); }
                  *(u32x4*)(VT + e * 72 + 32 * ch + 8 * q) = (u32x4){w[0], w[1], w[2], w[3]}; }
              for (int i = tid; i < 2048; i += 512) ZL[i] = GZ[rowb * 32 + i]; }
            __syncthreads();
            f32x16 o[2] = {};
#pragma unroll 1
            for (int dir = 0; dir < 2; ++dir) {
                const int d = tid & 127, cg = tid >> 7;
                float g[16];
                { float wv[16];
#pragma unroll
                  for (int r = 0; r < 16; ++r) wv[r] = wg[(size_t)(dir * 16 + r) * 512 + h * 128 + d];
                  const float bias = bgt[dir * 512 + h * 128 + d];
#pragma unroll
                  for (int i = 0; i < 16; ++i) { const float* z = ZL + (16 * cg + i) * 32 + dir * 16; float xg = bias;
#pragma unroll
                      for (int r = 0; r < 16; ++r) xg += z[r] * wv[r];
                      g[i] = logsigf(xg) * (1.f / 16.f); } }
                if (dir == 0) { for (int i = 1; i < 16; ++i) g[i] += g[i - 1]; TOT[cg * 128 + d] = g[15]; }
                else { for (int i = 14; i >= 0; --i) g[i] += g[i + 1]; TOT[cg * 128 + d] = g[0]; }
                __syncthreads();
                float pre = 0.f;
#pragma unroll
                for (int q = 0; q < 4; ++q) { const float t = TOT[q * 128 + d]; if (dir == 0 ? (q < cg) : (q > cg)) pre += t; }
#pragma unroll 4
                for (int i = 0; i < 16; ++i) { const int c = 16 * cg + i; const float bb = g[i] + pre;
                    const float qv = bf2f(GQ[(rowb + c) * 512 + h * 128 + d]), kv = bf2f(GK[(rowb + c) * 512 + h * 128 + d]);
                    QIN[c * 136 + d] = (bf16_t)(cvt_pk_bf16(qv * __expf(bb), 0.f) & 0xffffu);
                    KIN[c * 136 + d] = (bf16_t)(cvt_pk_bf16(kv * __expf(-bb), 0.f) & 0xffffu); }
                __syncthreads();
                if (wave < 4) { const int cb = wave >> 1, sb = wave & 1; f32x16 a = {};
#pragma unroll
                    for (int ks = 0; ks < 8; ++ks) { const bf16x8 qa = *(const bf16x8*)(QIN + (32 * cb + r32) * 136 + 16 * ks + 8 * hi), kb = *(const bf16x8*)(KIN + (32 * sb + r32) * 136 + 16 * ks + 8 * hi);
                        a = __builtin_amdgcn_mfma_f32_32x32x16_bf16(qa, kb, a, 0, 0, 0); }
#pragma unroll
                    for (int r = 0; r < 16; ++r) { const int c = 32 * cb + crow(r, hi), s = 32 * sb + r32; const bool keep = dir == 0 ? (s <= c) : (s >= c);
                        ATT[c * 72 + s] = (bf16_t)(cvt_pk_bf16(keep ? a[r] : 0.f, 0.f) & 0xffffu); } }
                __syncthreads();
                { const int seq = bh * 2 + dir;
                  const bf16_t* sg = DS + (((size_t)seq * NPC + pc) * 256 + 32 * wave + r32) * 128 + 8 * hi;
                  bf16x8 sfr[8];
#pragma unroll
                  for (int ks = 0; ks < 8; ++ks) sfr[ks] = *(const bf16x8*)(sg + 16 * ks);
#pragma unroll
                  for (int cb = 0; cb < 2; ++cb) {
#pragma unroll
                      for (int ks = 0; ks < 4; ++ks) { const bf16x8 a = *(const bf16x8*)(ATT + (32 * cb + r32) * 72 + 16 * ks + 8 * hi), bv = *(const bf16x8*)(VT + (32 * wave + r32) * 72 + 16 * ks + 8 * hi);
                          o[cb] = __builtin_amdgcn_mfma_f32_32x32x16_bf16(a, bv, o[cb], 0, 0, 0); }
#pragma unroll
                      for (int ks = 0; ks < 8; ++ks) { const bf16x8 a = *(const bf16x8*)(QIN + (32 * cb + r32) * 136 + 16 * ks + 8 * hi);
                          o[cb] = __builtin_amdgcn_mfma_f32_32x32x16_bf16(a, sfr[ks], o[cb], 0, 0, 0); } } }
                __syncthreads();
            }
#pragma unroll
            for (int cb = 0; cb < 2; ++cb)
#pragma unroll
                for (int r = 0; r < 16; ++r) OL[(32 * cb + crow(r, hi)) * 260 + 32 * wave + r32] = o[cb][r];
            __syncthreads();
            const f32x4 nw = *(const f32x4*)(INP(I_GNORM) + 4 * lane);
#pragma unroll 2
            for (int q = 0; q < 8; ++q) { const int c = 8 * wave + q;
                const f32x4 v = *(const f32x4*)(OL + c * 260 + 4 * lane);
                const float ssum = wave_sum(v[0] * v[0] + v[1] * v[1] + v[2] * v[2] + v[3] * v[3]);
                const float rstd = rsqrtf(ssum * (1.f / 256.f) + NORM_EPS);
                const u32x2 rr = *(const u32x2*)(GR + (rowb + c) * 1024 + h * 256 + 4 * lane);
                u32x2 ov; ov.x = cvt_pk_bf16(v[0] * rstd * nw[0] * siluf(bflo(rr.x)), v[1] * rstd * nw[1] * siluf(bfhi(rr.x)));
                ov.y = cvt_pk_bf16(v[2] * rstd * nw[2] * siluf(bflo(rr.y)), v[3] * rstd * nw[3] * siluf(bfhi(rr.y)));
                *(u32x2*)(AO + (rowb + c) * DM + h * 256 + 4 * lane) = ov; }
            __syncthreads();
        }
    }
    SEAM(13);

    if (IN(14)) {
        pg8::DenseOrder S; S.init(AO, WGOUT, TLAT, 1024, G, blk);
        pg8::EpiPlain E{YB};
        pg8::gemm_phase<pg8::EpiPlain, pg8::DenseOrder, true, true>((LAS unsigned char*)lds, S, E);
    }
    SEAM(14);

    }

    moe_layer<1>(ws, lds, bar, lo, hi_ph);
#undef IN
#undef SEAM
}


#ifndef MK_DEBUG
#define MK_DEBUG 0
#endif
#ifndef MK_DEBUG_CNT
#define MK_DEBUG_CNT 0
#endif
#ifndef MK_DEBUG_SUB
#define MK_DEBUG_SUB 0
#endif
#ifndef MK_DEBUG_MUL
#define MK_DEBUG_MUL 1
#endif
#if MK_DEBUG
__global__ void dbg_check(const void* p, size_t n, int kind, float lim, unsigned code, unsigned* flag) {
    unsigned bad = 0; size_t minidx = 0xFFFFFFFFull, maxidx = 0;
    for (size_t i = (size_t)blockIdx.x * blockDim.x + threadIdx.x; i < n; i += (size_t)gridDim.x * blockDim.x) {
        if (kind == 0) { const float v = bf2f(((const bf16_t*)p)[i]); if (!(fabsf(v) <= lim)) { ++bad; if (i < minidx) minidx = i; if (i > maxidx) maxidx = i; } }
        else if (kind == 1) { const float v = ((const float*)p)[i]; if (!(fabsf(v) <= lim)) ++bad; }
        else { const int v = ((const int*)p)[i]; if (v < 0 || v > (int)lim) ++bad; }
    }
    if (code == 0u) return;
    if (bad) { atomicAdd(flag + 1, bad); atomicCAS(flag, 0u, code); atomicMin(flag + 2, (unsigned)minidx); atomicMax(flag + 3, (unsigned)maxidx); }
}
__global__ void dbg_report(float* out, size_t n, const unsigned* flag) {
    const unsigned f = *flag;
    if (f == 0u) return;
    const unsigned cnt = flag[1];
    float val = 100.f * (float)f;
#if MK_DEBUG_CNT == 1
    val = 100.f * (float)(32 - __clz(cnt));
#elif MK_DEBUG_CNT == 2
    val = 100.f * (float)(1 + (flag[2] / 32768u) % 132u);
#elif MK_DEBUG_CNT == 3
    val = 100.f * (float)(1 + (flag[2] / 32768u) / 132u);
#elif MK_DEBUG_CNT == 4
    val = 100.f * (float)(1 + (flag[3] / 32768u) % 132u);
#elif MK_DEBUG_CNT == 6
    val = 100.f * (float)(1 + ((flag[2] % 32768u) / 128u) % 64u) + 10000.f * (float)(((flag[2] % 32768u) / 128u) / 64u);
#elif MK_DEBUG_CNT == 7
    val = 100.f * (float)(1 + (flag[2] % 128u) % 64u) + 10000.f * (float)((flag[2] % 128u) / 64u);
#elif MK_DEBUG_CNT == 5
    val = 100.f * (float)(1 + (flag[3] / 32768u) / 132u);
#endif
    for (size_t i = (size_t)blockIdx.x * blockDim.x + threadIdx.x; i < n; i += (size_t)gridDim.x * blockDim.x) out[i] = val;
}
#endif

extern "C" void kernel_launch(void* const* d_in, const int* in_sizes, int n_in, void* d_out, int out_size, void* d_ws, size_t ws_size, hipStream_t stream) {
    static int grid = 0;
    if (grid == 0) {
        if (n_in != 23 || out_size != TLAT * DM || ws_size < WS_END) { fprintf(stderr, "kernel_launch: unexpected shapes (n_in %d, out %d, ws %zu, need %zu)\n", n_in, out_size, ws_size, (size_t)WS_END); grid = -1; return; }
        int dev = 0, cus = 0;
        if (hipGetDevice(&dev) != hipSuccess || hipDeviceGetAttribute(&cus, hipDeviceAttributeMultiprocessorCount, dev) != hipSuccess) { grid = -1; return; }
        if (hipFuncSetAttribute((const void*)fwd_kernel, hipFuncAttributeMaxDynamicSharedMemorySize, LDS_BYTES) != hipSuccess) { fprintf(stderr, "kernel_launch: hipFuncSetAttribute failed\n"); grid = -1; return; }
        int per_cu = 0;
        if (hipOccupancyMaxActiveBlocksPerMultiprocessor(&per_cu, (const void*)fwd_kernel, 512, LDS_BYTES) != hipSuccess || per_cu < 1) { fprintf(stderr, "kernel_launch: occupancy query says %d\n", per_cu); }
        (void)hipGetLastError();
        grid = cus;
        if (grid != 256) fprintf(stderr, "kernel_launch: %d CUs (built for 256)\n", grid);
    }
    if (grid < 0) return;
    (void)hipMemsetAsync((char*)d_ws + WS_CTL, 0, CTL_ZERO_BYTES, stream);
    Args a{};
    for (int i = 0; i < 23; ++i) a.in[i] = (const float*)d_in[i];
    a.out = (float*)d_out; a.ws = (unsigned char*)d_ws;
#if MK_DEBUG
    (void)hipMemsetAsync((char*)d_ws + CTL_ZERO_BYTES, 0xFF, WS_END - CTL_ZERO_BYTES, stream);
    unsigned* flag = (unsigned*)((char*)d_ws + 32768);
    (void)hipMemsetAsync((char*)d_ws + 32768 + 8, 0xFF, 4, stream);
    unsigned char* w = (unsigned char*)d_ws;
#define CHK(ptr, n, kind, lim, code) hipLaunchKernelGGL(dbg_check, dim3(1024), dim3(256), 0, stream, (const void*)(ptr), (size_t)(n), kind, (float)(lim), (unsigned)(MK_DEBUG_SUB ? ((code) - c + 1) * ((p) == MK_DEBUG_SUB - 1) : c), flag)
    for (int p = 0; p < MK_MAX_PHASE; ++p) { a.ph_lo = p; a.ph_hi = p + 1; hipLaunchKernelGGL(fwd_kernel, dim3(grid), dim3(512), LDS_BYTES, stream, a);
        const int c = (p + 1) * MK_DEBUG_MUL;
        switch (p) {
        case 0: CHK(w + WS_MOD, 2 * 5 * 6144, 1, 1e4, c); CHK(w + WS_ROPE, 4096, 1, 1.01, c + 1); CHK(w + WS_WQKV, 3072 * 1024, 0, 1e3, c + 2); CHK(w + WS_WO, 1024 * 1024, 0, 1e3, c + 2); CHK(w + WS_WGIN, GIN_NP * 1024, 0, 1e3, c + 3); CHK(w + WS_WGOUT, 1024 * 1024, 0, 1e3, c + 3);
                CHK(w + WS_WGU, (size_t)64 * 2048 * 1024, 0, 1e3, c + 4); CHK(w + WS_WD, (size_t)64 * 1024 * 1024, 0, 1e3, c + 4); break;
        case 1: CHK(w + WS_T, (size_t)T0 * DM, 0, 1e4, c); break;
        case 2: CHK(w + WS_Q, (size_t)T0 * DM, 0, 1e4, c); CHK(w + WS_KC, (size_t)T0 * DM, 0, 1e4, c + 1); CHK(w + WS_VC, (size_t)T0 * DM, 0, 1e4, c + 2); break;
        case 3: CHK(w + WS_AO, (size_t)T0 * DM, 0, 1e3, c); break;
        case 4: CHK(w + WS_Y, (size_t)T0 * DM, 0, 1e4, c); break;
        case 5: CHK(w + WS_X1, (size_t)T0 * DM, 1, 1e3, c); CHK(w + WS_U, (size_t)T0 * DM, 0, 1e4, c + 1); CHK(w + WS_TOKG, (size_t)T0 * 4, 1, 1.01, c + 2); CHK(w + WS_TOKE, (size_t)T0 * 4, 2, 31, c + 3); CHK(w + WS_HIST, 256 * 32, 2, 600, c + 4); break;
        case 6: CHK(w + WS_TOKR, (size_t)T0 * 4, 2, MAXRB * 256 - 1, c); CHK(w + WS_BLKEXP + 4092, 1, 2, MAXRB, c + 1); break;
        case 9: CHK(w + WS_X2, (size_t)T0 * DM, 1, 1e3, c); CHK(w + WS_T, (size_t)T0 * DM, 0, 1e4, c + 1); break;
        case 10: CHK(w + WS_Q, (size_t)T0 * DM, 0, 1e4, c); CHK(w + WS_KC, (size_t)T0 * DM, 0, 1e4, c + 1); CHK(w + WS_VC, (size_t)T0 * DM, 0, 1e4, c + 2); CHK(w + WS_GZ, (size_t)T0 * 32, 1, 1e4, c + 3); break;
        case 11: CHK(w + WS_H, (size_t)32 * NPC * 256 * 128, 0, 1e5, c); CHK(w + WS_DEC, (size_t)32 * NPC * 128, 1, 1.01, c + 1); break;
        case 12: CHK(w + WS_H, (size_t)32 * NPC * 256 * 128, 0, 1e6, c); break;
        case 13: CHK(w + WS_AO, (size_t)TLAT * DM, 0, 1e4, c); break;
        case 14: CHK(w + WS_Y, (size_t)TLAT * DM, 0, 1e4, c); break;
        case 15: CHK(w + WS_X1, (size_t)TLAT * DM, 1, 1e3, c); CHK(w + WS_U, (size_t)TLAT * DM, 0, 1e4, c + 1); CHK(w + WS_TOKG, (size_t)TLAT * 4, 1, 1.01, c + 2); CHK(w + WS_TOKE, (size_t)TLAT * 4, 2, 31, c + 3); CHK(w + WS_HIST, 256 * 32, 2, 600, c + 4); break;
        case 16: CHK(w + WS_TOKR, (size_t)TLAT * 4, 2, MAXRB * 256 - 1, c); CHK(w + WS_BLKEXP + 4092, 1, 2, MAXRB, c + 1); break;
        case 19: CHK(d_out, (size_t)TLAT * DM, 1, 1e3, c); break;
        default: break;
        }
    }
    hipLaunchKernelGGL(dbg_report, dim3(1024), dim3(256), 0, stream, (float*)d_out, (size_t)TLAT * DM, (const unsigned*)flag);
#elif MK_PER_PHASE
    for (int p = 0; p < MK_MAX_PHASE; ++p) { a.ph_lo = p; a.ph_hi = p + 1; hipLaunchKernelGGL(fwd_kernel, dim3(grid), dim3(512), LDS_BYTES, stream, a); }
#else
    a.ph_lo = 0; a.ph_hi = NPHASE;
    hipLaunchKernelGGL(fwd_kernel, dim3(grid), dim3(512), LDS_BYTES, stream, a);
#endif
    const hipError_t le = hipPeekAtLastError();
    if (le != hipSuccess) fprintf(stderr, "kernel_launch: launch failed: %s\n", hipGetErrorName(le));
}
```

```cpp
#include <hip/hip_runtime.h>
#include <cstdio>
#include <cstdint>

#ifndef MK_MAX_PHASE
#define MK_MAX_PHASE 20
#endif
#ifndef MK_PROBE_ATT
#define MK_PROBE_ATT -1
#endif
#ifndef MK_PVAR_PH
#define MK_PVAR_PH -1
#endif
#ifndef MK_PVAR
#define MK_PVAR 0
#endif
#ifndef MK_REP_PH
#define MK_REP_PH -1
#endif
#ifndef MK_REP_N
#define MK_REP_N 2
#endif
#ifndef MK_PER_PHASE
#define MK_PER_PHASE 0
#endif

#define LAS __attribute__((address_space(3)))
typedef unsigned short bf16_t;
typedef short bf16x8 __attribute__((ext_vector_type(8)));
typedef short s16x4 __attribute__((ext_vector_type(4)));
typedef float f32x2 __attribute__((ext_vector_type(2)));
typedef float f32x4 __attribute__((ext_vector_type(4)));
typedef float f32x16 __attribute__((ext_vector_type(16)));
typedef unsigned u32x2 __attribute__((ext_vector_type(2)));
typedef unsigned u32x4 __attribute__((ext_vector_type(4)));

constexpr int DM = 1024, NB = 4, SEQ = 8192, NCTX = 256;
constexpr int TLAT = NB * SEQ, TCTX = NB * NCTX, T0 = TLAT + TCTX;
constexpr int KVLEN = NCTX + SEQ;
constexpr int NEXP = 32, TOPK = 4;
constexpr int MAXRB = 560;
constexpr int GIN_N = 3104, GIN_NP = 3328;
constexpr int NPC = 132;
constexpr float ALPHA = 1.4142135623730951f;
constexpr float NORM_EPS = 1e-5f;
constexpr float QSCALE = 0.125f * 1.4426950408889634f;
constexpr float LAM_INIT0 = 0.2f;
constexpr int NPHASE = 20;

constexpr size_t MiB = 1u << 20;
constexpr size_t WS_CTL = 0;
constexpr size_t CTL_ZERO_BYTES = 64 * 1024;
constexpr size_t WS_MOD = 1 * MiB;
constexpr size_t WS_ROPE = WS_MOD + 256 * 1024;
constexpr size_t WS_HIST = WS_ROPE + 16 * 1024;
constexpr size_t WS_BLKEXP = WS_HIST + 32 * 1024;
constexpr size_t WS_WGT = WS_BLKEXP + 4096;
constexpr size_t WS_TOKE = 2 * MiB;
constexpr size_t WS_TOKG = WS_TOKE + 1 * MiB;
constexpr size_t WS_TOKR = WS_TOKG + 1 * MiB;
constexpr size_t WS_ROWTOK = 5 * MiB;
constexpr size_t WS_GZ = 6 * MiB;
constexpr size_t WS_DEC = 11 * MiB;
constexpr size_t WS_WQKV = 14 * MiB;
constexpr size_t WS_WO = WS_WQKV + 6 * MiB;
constexpr size_t WS_WGIN = WS_WO + 2 * MiB;
constexpr size_t WS_WGOUT = WS_WGIN + 7 * MiB;
constexpr size_t WS_WGU = 32 * MiB;
constexpr size_t WS_WD = WS_WGU + 256 * MiB;
constexpr size_t ACT = (size_t)T0 * DM * 2;
constexpr size_t WS_T = WS_WD + 128 * MiB;
constexpr size_t WS_Q = WS_T + ACT;
constexpr size_t WS_KC = WS_Q + ACT;
constexpr size_t WS_VC = WS_KC + ACT;
constexpr size_t WS_AO = WS_VC + ACT;
constexpr size_t WS_Y = WS_AO + ACT;
constexpr size_t WS_U = WS_Y + ACT;
constexpr size_t WS_X1 = WS_U + ACT;
constexpr size_t WS_X2 = WS_X1 + 2 * ACT;
constexpr size_t XSB = (size_t)MAXRB * 256 * DM * 2;
constexpr size_t WS_XS = WS_X2 + 2 * ACT;
constexpr size_t WS_H = WS_XS + XSB;
constexpr size_t WS_END = WS_H + XSB;

constexpr int LDS_MAIN = 131072;
constexpr int LDS_MISC = 147456;
constexpr int LDS_BYTES = LDS_MISC + 8192;

typedef __bf16 bf16x2_t __attribute__((ext_vector_type(2)));
__device__ __forceinline__ unsigned cvt_pk_bf16(float lo, float hi) { const f32x2 v = {lo, hi}; const bf16x2_t b = __builtin_convertvector(v, bf16x2_t); return __builtin_bit_cast(unsigned, b); }
__device__ __forceinline__ float bf2f(unsigned short b) { return __builtin_bit_cast(float, (unsigned)b << 16); }
__device__ __forceinline__ float bflo(unsigned w) { return __builtin_bit_cast(float, w << 16); }
__device__ __forceinline__ float bfhi(unsigned w) { return __builtin_bit_cast(float, w & 0xffff0000u); }
__device__ __forceinline__ f32x4 bf4_f32(u32x2 w) { return (f32x4){bflo(w.x), bfhi(w.x), bflo(w.y), bfhi(w.y)}; }
template <int CTRL> __device__ __forceinline__ float dpp_f(float v) { return __builtin_bit_cast(float, __builtin_amdgcn_update_dpp(0, __builtin_bit_cast(int, v), CTRL, 0xF, 0xF, true)); }
template <int CTRL> __device__ __forceinline__ int dpp_i(int v) { return __builtin_amdgcn_update_dpp(0, v, CTRL, 0xF, 0xF, true); }
__device__ __forceinline__ float rl_f(float v, int l) { return __builtin_bit_cast(float, __builtin_amdgcn_readlane(__builtin_bit_cast(int, v), l)); }
__device__ __forceinline__ float row16_sum(float v) { v += dpp_f<0xB1>(v); v += dpp_f<0x4E>(v); v += dpp_f<0x141>(v); v += dpp_f<0x140>(v); return v; }
__device__ __forceinline__ float row16_max(float v) { v = fmaxf(v, dpp_f<0xB1>(v)); v = fmaxf(v, dpp_f<0x4E>(v)); v = fmaxf(v, dpp_f<0x141>(v)); v = fmaxf(v, dpp_f<0x140>(v)); return v; }
__device__ __forceinline__ int row16_min(int v) { v = min(v, dpp_i<0xB1>(v)); v = min(v, dpp_i<0x4E>(v)); v = min(v, dpp_i<0x141>(v)); v = min(v, dpp_i<0x140>(v)); return v; }
__device__ __forceinline__ float wave_sum(float v) { v = row16_sum(v); return (rl_f(v, 0) + rl_f(v, 16)) + (rl_f(v, 32) + rl_f(v, 48)); }
__device__ __forceinline__ float half32_sum(float v) { v = row16_sum(v); return v + __builtin_bit_cast(float, __builtin_amdgcn_ds_swizzle(__builtin_bit_cast(int, v), 0x401F)); }
__device__ __forceinline__ float half_max(float v, int hh) { v = row16_max(v); const float a = fmaxf(rl_f(v, 0), rl_f(v, 16)), b = fmaxf(rl_f(v, 32), rl_f(v, 48)); return hh ? b : a; }
__device__ __forceinline__ int half_min(int v, int hh) { v = row16_min(v); const int a = min(__builtin_amdgcn_readlane(v, 0), __builtin_amdgcn_readlane(v, 16)), b = min(__builtin_amdgcn_readlane(v, 32), __builtin_amdgcn_readlane(v, 48)); return hh ? b : a; }
__device__ __forceinline__ float siluf(float x) { return x / (1.f + __expf(-x)); }
__device__ __forceinline__ float logsigf(float x) { return fminf(x, 0.f) - __logf(1.f + __expf(-fabsf(x))); }
__device__ __forceinline__ int crow(int r, int hi) { return (r & 3) + 8 * (r >> 2) + 4 * hi; }
#define LDS_WAIT() asm volatile("s_waitcnt lgkmcnt(0)" ::: "memory")
__device__ __forceinline__ int opaque_lane() { int l; asm volatile("v_mbcnt_lo_u32_b32 %0, -1, 0\n\tv_mbcnt_hi_u32_b32 %0, -1, %0" : "=v"(l)); return l; }
#define SBAR() __builtin_amdgcn_sched_barrier(0)

enum { I_X = 0, I_C, I_CTX, I_CCTX, I_ADAW, I_ADAB, I_LNG, I_LNB, I_DAWIN, I_DAWOUT, I_DALAM, I_DASUBLN, I_GWIN, I_GWGATE, I_GBGATE, I_GNORM, I_GWOUT,
       I_RW, I_RB, I_WGU, I_BGU, I_WD, I_BD };
__device__ __forceinline__ const float* inptr(const unsigned char* lds, int i) {
    const u32x2 v = *(const u32x2*)(lds + LDS_MISC + 64 + 8 * i);
    const unsigned long long p = ((unsigned long long)(unsigned)__builtin_amdgcn_readfirstlane((int)v.y) << 32) | (unsigned)__builtin_amdgcn_readfirstlane((int)v.x);
    return (const float*)p;
}
#define INP(i) inptr(lds, (i))

#define XB_TMO      128
#define XB_XCNT(j)  (256  + 64 * (j))
#define XB_XSUB(j)  (1280 + 64 * (j))
#define XB_XGEN(j)  (2304 + 64 * (j))
#define XB_TOP      3328
#define XB_TOPGEN   3392
#define XCD_BAR_WORDS 3456
#define XB_SPIN_CAP (1u << 18)
__device__ __forceinline__ unsigned xb_ld(unsigned* p)              { return __hip_atomic_load(p, __ATOMIC_RELAXED, __HIP_MEMORY_SCOPE_AGENT); }
__device__ __forceinline__ unsigned xb_add(unsigned* p, unsigned v) { return __hip_atomic_fetch_add(p, v, __ATOMIC_RELAXED, __HIP_MEMORY_SCOPE_AGENT); }
__device__ __forceinline__ unsigned xb_xcc_id() { return (unsigned)__builtin_amdgcn_s_getreg((3 << 11) | 20) & 0xFu; }
#define XB_SPIN(cond, bar) do { unsigned _sp = 0; while (cond) { __builtin_amdgcn_s_sleep(1); \
    if ((++_sp & 255u) == 0u) { if (xb_ld(&(bar)[XB_TMO])) break; if (_sp > XB_SPIN_CAP) { atomicAdd(&(bar)[XB_TMO], 1u); break; } } } } while (0)
struct XcdBarrier { unsigned* bar; unsigned x; volatile LAS unsigned* st; };
__device__ __forceinline__ XcdBarrier xcd_barrier_post(unsigned* bar, volatile LAS unsigned* st, bool leader  ) {
    XcdBarrier b; b.bar = bar; b.x = xb_xcc_id(); b.st = st;
    if (leader) (void)xb_add(&bar[XB_XCNT(b.x)], 1u);
    return b;
}
__device__ __forceinline__ void xcd_barrier_complete(unsigned* bar, unsigned x, unsigned& nloc, unsigned& nx) {
    const unsigned G = gridDim.x * gridDim.y * gridDim.z;
    unsigned sum, cnt, mine, sp = 0u;
    for (;;) {
        sum = 0u; cnt = 0u; mine = 0u;
#pragma unroll
        for (unsigned j = 0; j < 16; ++j) { const unsigned c = xb_ld(&bar[XB_XCNT(j)]); sum += c; cnt += (c > 0u) ? 1u : 0u; mine = (j == x) ? c : mine; }
        if (sum == G) break;
        __builtin_amdgcn_s_sleep(1);
        if ((++sp & 255u) == 0u) { if (xb_ld(&bar[XB_TMO])) break; if (sp > XB_SPIN_CAP) { atomicAdd(&bar[XB_TMO], 1u); break; } }
    }
    nloc = mine > 0u ? mine : 1u; nx = cnt > 0u ? cnt : 1u;
}
__device__ __forceinline__ void xcd_barrier(const XcdBarrier& b, bool leader) {
    asm volatile("s_waitcnt vmcnt(0)" ::: "memory");
    __syncthreads();
    if (leader) {
        unsigned* bar = b.bar;
        __builtin_amdgcn_s_waitcnt(0);
        unsigned nloc = b.st[0], nx = b.st[1];
        if (nloc == 0u) { xcd_barrier_complete(bar, b.x, nloc, nx); b.st[0] = nloc; b.st[1] = nx; }
        const unsigned old = xb_add(&bar[XB_XSUB(b.x)], 1u);
        const unsigned gen = old / nloc;
        if (old + 1u == (gen + 1u) * nloc) {
            __builtin_amdgcn_fence(__ATOMIC_RELEASE, "agent");
            asm volatile("s_waitcnt vmcnt(0)" ::: "memory");
            const unsigned og = xb_add(&bar[XB_TOP], 1u);
            const unsigned tg = og / nx;
            if (og + 1u == (tg + 1u) * nx) xb_add(&bar[XB_TOPGEN], 1u);
            else XB_SPIN(xb_ld(&bar[XB_TOPGEN]) == tg, bar);
            __builtin_amdgcn_fence(__ATOMIC_ACQUIRE, "agent");
            xb_add(&bar[XB_XGEN(b.x)], 1u);
            asm volatile("s_waitcnt vmcnt(0)" ::: "memory");
        } else {
            XB_SPIN(xb_ld(&bar[XB_XGEN(b.x)]) == gen, bar);
            __builtin_amdgcn_fence(__ATOMIC_ACQUIRE, "agent");
            asm volatile("s_waitcnt vmcnt(0)" ::: "memory");
        }
    }
    __syncthreads();
}

namespace pg8 {
constexpr int BM = 256, BK = 64, HALF = 128, HTB = HALF * BK * 2, STAGE_BYTES = 8 * HTB, NXCD = 8, WGM = 8, K = 1024;
typedef int v4i __attribute__((ext_vector_type(4)));
typedef int v8i __attribute__((ext_vector_type(8)));
__host__ __device__ __forceinline__ int lds_byte(int r, int c) { const int st = (r >> 4) * 2 + (c >> 5), rr = r & 15, cc = c & 31, ob = rr * 64 + cc * 2; return st * 1024 + (ob ^ (((ob >> 9) & 1) << 5)); }
__host__ __device__ __forceinline__ void stage_rc(int b, int& R, int& C) { const int st = b / 1024, sb = b % 1024, swz = sb ^ (((sb >> 9) & 1) << 5); R = (st >> 1) * 16 + swz / 64; C = (st & 1) * 32 + (swz % 64) / 2; }
__host__ __device__ __forceinline__ int perm32(int rho) { const int n = rho >> 4, i = rho & 15; return 8 * (i >> 2) + 4 * n + (i & 3); }
struct Unit { int pm, pn, e; };
constexpr size_t TSTEP = (size_t)BM * K * 2;

struct DenseOrder {
    const char* A; const char* Bt; int nM, nN, nwg, G, c; unsigned tstep;
    __device__ void init(const void* A_, const void* Bt_, int M, int N, int G_, int c_, int eb_ = 2) { A = (const char*)A_; Bt = (const char*)Bt_; nM = M / BM; nN = N / BM; nwg = nM * nN; G = G_; c = c_; tstep = (unsigned)(BM * K * eb_); }
    __device__ bool next(int i, Unit& u) const {
        const int L = i * G + c; if (L >= nwg) return false;
        int wgid = L; { const int q = nwg / NXCD, r = nwg % NXCD, xcd = wgid % NXCD, off = wgid / NXCD; wgid = (xcd < r ? xcd * (q + 1) : r * (q + 1) + (xcd - r) * q) + off; }
        const int nig = WGM * nN, gid = wgid / nig, fm = gid * WGM, gsz = (nM - fm) < WGM ? (nM - fm) : WGM;
        u.pm = fm + ((wgid % nig) % gsz); u.pn = (wgid % nig) / gsz; u.e = 0; return true;
    }
    __device__ __forceinline__ unsigned a_off(const Unit& u) const { return (unsigned)u.pm * tstep; }
    __device__ __forceinline__ unsigned b_off(const Unit& u) const { return (unsigned)u.pn * tstep; }
};
#ifndef MOE_XCD_ORDER
#define MOE_XCD_ORDER 0
#endif
struct MoeOrder {
    const char* A; const char* Bt; const int* blkexp; int ncol, nunits, G, c; unsigned tstep;
    int f0, f1, f2, f3, c0, c1, c2, c3;
    __device__ void init(const void* A_, const void* Bt_, const int* blkexp_, int nblk, int ncol_, int G_, int c_, int eb_ = 2) { A = (const char*)A_; Bt = (const char*)Bt_; blkexp = blkexp_; ncol = ncol_; nunits = nblk * ncol_; G = G_; c = c_; tstep = (unsigned)(BM * K * eb_);
#if MOE_XCD_ORDER
        { const int e = c_ & 7;
          f0 = __builtin_amdgcn_readfirstlane(blkexp_[600 + e]); f1 = __builtin_amdgcn_readfirstlane(blkexp_[608 + e]); f2 = __builtin_amdgcn_readfirstlane(blkexp_[616 + e]); f3 = __builtin_amdgcn_readfirstlane(blkexp_[624 + e]);
          c0 = __builtin_amdgcn_readfirstlane(blkexp_[640 + e]) * ncol_; c1 = __builtin_amdgcn_readfirstlane(blkexp_[648 + e]) * ncol_; c2 = __builtin_amdgcn_readfirstlane(blkexp_[656 + e]) * ncol_; c3 = __builtin_amdgcn_readfirstlane(blkexp_[664 + e]) * ncol_; }
#endif
    }
    __device__ bool next(int i, Unit& u) const {
#if MOE_XCD_ORDER
        if ((G & 7) == 0) {
            int idx = i * (G >> 3) + (c >> 3);
            int fj, ej = c & 7;
            if (idx < c0) fj = f0; else { idx -= c0; ej += 8; if (idx < c1) fj = f1; else { idx -= c1; ej += 8; if (idx < c2) fj = f2; else { idx -= c2; ej += 8; if (idx < c3) fj = f3; else return false; } } }
            u.pm = fj + idx / ncol; u.pn = idx % ncol; u.e = ej; return true;
        }
#endif
        const int L = i * G + c; if (L >= nunits) return false;
        u.pm = L / ncol; u.pn = L % ncol; u.e = __builtin_amdgcn_readfirstlane(blkexp[u.pm]); return true;
    }
    __device__ __forceinline__ unsigned a_off(const Unit& u) const { return (unsigned)u.pm * tstep; }
    __device__ __forceinline__ unsigned b_off(const Unit& u) const { return (unsigned)(u.e * ncol + u.pn) * tstep; }
};

template <class Epi, class Sched, bool ALIGN_EPI, bool SP2, int EB = 2, bool GATHER = false>
__device__ __forceinline__ void gemm_phase(LAS unsigned char* lds, const Sched& S, const Epi& E, const int wid  , const unsigned* rowoff = nullptr) {
    static_assert(!GATHER || SP2, "the gathered A path is written for the SP2 schedule");
    const int lane = opaque_lane(), tid = wid * 64 + lane, wr = wid >> 2, wc = wid & 3, fr = lane & 15, fq = lane >> 4;
    constexpr int ROWB = K * EB;
    constexpr int nt = ROWB / 128;
    unsigned voffA[2], voffB[2];
#pragma unroll
    for (int i = 0; i < 2; ++i) { int R, C; stage_rc(tid * 16 + i * 8192, R, C); const int Rb = (R & ~31) + perm32(R & 31);
        voffA[i] = (unsigned)(R * ROWB + C * 2); voffB[i] = (unsigned)(Rb * ROWB + C * 2); }
    constexpr unsigned kstep = (unsigned)(BK * 2);
    constexpr unsigned hstep = (unsigned)(HALF * ROWB);
    constexpr unsigned hsA = GATHER ? 0u : hstep;
    constexpr int GT_BASE = 131072;
    unsigned cofA = 0u; LAS unsigned char* gtl = lds;
    const __amdgpu_buffer_rsrc_t rsrcT = __builtin_amdgcn_make_buffer_rsrc((void*)(GATHER ? (const void*)rowoff : (const void*)S.A), 0, 0x7fffffff, 0x00020000);
    if constexpr (GATHER) { const int lz_ = opaque_lane(); int R_, C_; stage_rc((wid * 64 + lz_) * 16, R_, C_); cofA = (unsigned)(C_ * 2); gtl = lds + GT_BASE + wid * 2048 + lz_ * 4; }
#define PG8_TOKDMA(pm_, SLOT_) do { const int lq_ = opaque_lane(); int Rq_, Cq_; stage_rc((wid * 64 + lq_) * 16, Rq_, Cq_); (void)Cq_; _Pragma("unroll") for (int e_ = 0; e_ < 4; ++e_) \
        __builtin_amdgcn_raw_ptr_buffer_load_lds(rsrcT, (LAS void*)(lds + GT_BASE + wid * 2048 + (SLOT_) + e_ * 256), 4, Rq_ * 4, ((pm_) * 256 + e_ * 64) * 4, 0, 0); } while (0)
#define PG8_AOFF(dst, SLOT_, H_) do { dst[0] = *(const LAS unsigned*)(gtl + (SLOT_) + (H_) * 512) + cofA; dst[1] = *(const LAS unsigned*)(gtl + (SLOT_) + (H_) * 512 + 256) + cofA; } while (0)
    const unsigned ldsw = (unsigned)wid * 1024u;
    const int aoff = lds_byte(wr * 64 + fr, fq * 8), boff = lds_byte(wc * 32 + fr, fq * 8);
#define PG8_SA(b, h) (((b) * 2 + (h)) * HTB)
#define PG8_SB(b, h) ((4 + (b) * 2 + (h)) * HTB)
    const __amdgpu_buffer_rsrc_t rsrcA = __builtin_amdgcn_make_buffer_rsrc((void*)S.A, 0, 0x7fffffff, 0x00020000), rsrcB = __builtin_amdgcn_make_buffer_rsrc((void*)S.Bt, 0, 0x7fffffff, 0x00020000);
#define PG8_STAGE(bufoff, rs, soff, voff) do { _Pragma("unroll") for (int _i = 0; _i < 2; ++_i) \
        __builtin_amdgcn_raw_ptr_buffer_load_lds(rs, (LAS void*)(lds + (bufoff) + ldsw + _i * 8192), 16, (int)(voff)[_i], (int)(soff), 0, 0); } while (0)
#define PG8_LDA(dst, b, h) do { _Pragma("unroll") for (int m = 0; m < 4; ++m) { const v4i lo_ = *(const LAS v4i*)(lds + PG8_SA(b, h) + aoff + m * 2048), hi_ = *(const LAS v4i*)(lds + PG8_SA(b, h) + aoff + m * 2048 + 1024); \
        dst[m] = __builtin_shufflevector(lo_, hi_, 0, 1, 2, 3, 4, 5, 6, 7); } } while (0)
#define PG8_LDB(dst, b, h) do { _Pragma("unroll") for (int n = 0; n < 2; ++n) { const v4i lo_ = *(const LAS v4i*)(lds + PG8_SB(b, h) + boff + n * 2048), hi_ = *(const LAS v4i*)(lds + PG8_SB(b, h) + boff + n * 2048 + 1024); \
        dst[n] = __builtin_shufflevector(lo_, hi_, 0, 1, 2, 3, 4, 5, 6, 7); } } while (0)
#define PG8_HALF(v_, k_) __builtin_bit_cast(bf16x8, __builtin_shufflevector(v_, v_, 4 * (k_), 4 * (k_) + 1, 4 * (k_) + 2, 4 * (k_) + 3))
#define PG8_MMA(ai, bj, At, Bt) do { __builtin_amdgcn_s_setprio(1); _Pragma("unroll") for (int m = 0; m < 4; ++m) _Pragma("unroll") for (int n = 0; n < 2; ++n) { \
        if constexpr (EB == 1) acc[ai][bj][m][n] = __builtin_amdgcn_mfma_scale_f32_16x16x128_f8f6f4(Bt[n], At[m], acc[ai][bj][m][n], 0, 0, 0, 0x7F7F7F7F, 0, 0x7F7F7F7F); \
        else { acc[ai][bj][m][n] = __builtin_amdgcn_mfma_f32_16x16x32_bf16(PG8_HALF(Bt[n], 0), PG8_HALF(At[m], 0), acc[ai][bj][m][n], 0, 0, 0); \
               acc[ai][bj][m][n] = __builtin_amdgcn_mfma_f32_16x16x32_bf16(PG8_HALF(Bt[n], 1), PG8_HALF(At[m], 1), acc[ai][bj][m][n], 0, 0, 0); } } \
        __builtin_amdgcn_s_setprio(0); } while (0)
#define PG8_WAIT_V(n) asm volatile("s_waitcnt vmcnt(" #n ")" ::: "memory")
#define PG8_WAIT_L(n) asm volatile("s_waitcnt lgkmcnt(" #n ")" ::: "memory")
#define PG8_BAR __builtin_amdgcn_s_barrier()
#define PG8_SCHED __builtin_amdgcn_sched_barrier(0)
    Unit cur, nxt; int ui = 0;
    if (!S.next(0, cur)) return;
    f32x4 acc[2][2][4][2];
#pragma unroll
    for (int a = 0; a < 2; ++a)
#pragma unroll
        for (int b = 0; b < 2; ++b)
#pragma unroll
            for (int m = 0; m < 4; ++m)
#pragma unroll
                for (int n = 0; n < 2; ++n) acc[a][b][m][n] = (f32x4){0.f, 0.f, 0.f, 0.f};
    v8i At[4], B0[2], B1[2];
    unsigned cA = GATHER ? 0u : S.a_off(cur), cB = S.b_off(cur);
    if constexpr (SP2) {
        unsigned w0_[2], w1_[2]; w0_[0] = w1_[0] = voffA[0]; w0_[1] = w1_[1] = voffA[1];
        if constexpr (GATHER) { PG8_TOKDMA(cur.pm, 0); { Unit n1_; if (S.next(1, n1_)) PG8_TOKDMA(n1_.pm, 1024); } PG8_WAIT_V(0); PG8_AOFF(w0_, 0, 0); PG8_AOFF(w1_, 0, 1); }
        PG8_STAGE(PG8_SB(0, 0), rsrcB, cB, voffB); PG8_STAGE(PG8_SB(0, 1), rsrcB, cB + hstep, voffB); PG8_STAGE(PG8_SA(0, 0), rsrcA, cA, w0_); PG8_STAGE(PG8_SA(0, 1), rsrcA, cA + hsA, w1_);
        if (wr == 1) PG8_BAR;
        PG8_WAIT_V(2); PG8_BAR;
        PG8_STAGE(PG8_SB(1, 0), rsrcB, cB + kstep, voffB); PG8_STAGE(PG8_SA(1, 0), rsrcA, cA + kstep, w0_); PG8_STAGE(PG8_SB(1, 1), rsrcB, cB + hstep + kstep, voffB);
        PG8_WAIT_V(6); PG8_BAR;
    } else {
        PG8_STAGE(PG8_SB(0, 0), rsrcB, cB, voffB); PG8_STAGE(PG8_SA(0, 0), rsrcA, cA, voffA); PG8_STAGE(PG8_SB(0, 1), rsrcB, cB + hstep, voffB); PG8_STAGE(PG8_SA(0, 1), rsrcA, cA + hstep, voffA);
        if (wr == 1) PG8_BAR;
        PG8_WAIT_V(4); PG8_BAR;
        PG8_STAGE(PG8_SB(1, 0), rsrcB, cB + kstep, voffB); PG8_STAGE(PG8_SA(1, 0), rsrcA, cA + kstep, voffA); PG8_STAGE(PG8_SB(1, 1), rsrcB, cB + hstep + kstep, voffB);
        PG8_WAIT_V(6); PG8_BAR;
    }
    for (;;) {
        const bool has_next = S.next(ui + 1, nxt);
        const unsigned nA = GATHER ? 0u : (has_next ? S.a_off(nxt) : cA), nB = has_next ? S.b_off(nxt) : cB;
        const int scur = (ui & 1) * 1024, snxt = scur ^ 1024;
        if constexpr (GATHER) { if (ui > 0 && has_next) PG8_TOKDMA(nxt.pm, snxt); }
        asm volatile(".p2align 8" ::: "memory");
#pragma unroll 1
        for (int t = 0; t < nt; t += 2) {
            const bool last = (t == nt - 2);
            const unsigned a1 = cA + (unsigned)(t + 1) * kstep;
            const unsigned a2 = last ? nA : cA + (unsigned)(t + 2) * kstep, b2 = last ? nB : cB + (unsigned)(t + 2) * kstep;
            const unsigned a3 = a2 + kstep, b3 = b2 + kstep;
            if constexpr (SP2) {
            const int ssel = last ? snxt : scur;
            unsigned wa_[2]; wa_[0] = voffA[0]; wa_[1] = voffA[1];
            if constexpr (GATHER) PG8_AOFF(wa_, scur, 1);
            PG8_LDB(B0, 0, 0); PG8_LDB(B1, 0, 1); PG8_SCHED; PG8_LDA(At, 0, 0); PG8_STAGE(PG8_SA(1, 1), rsrcA, a1 + hsA, wa_);
            if constexpr (GATHER) PG8_AOFF(wa_, ssel, 0);
            PG8_WAIT_V(8); PG8_WAIT_L(0); PG8_BAR; PG8_MMA(0, 0, At, B0); PG8_MMA(0, 1, At, B1); PG8_BAR; PG8_SCHED;
            PG8_LDA(At, 0, 1); PG8_STAGE(PG8_SB(0, 0), rsrcB, b2, voffB); PG8_STAGE(PG8_SB(0, 1), rsrcB, b2 + hstep, voffB); PG8_STAGE(PG8_SA(0, 0), rsrcA, a2, wa_);
            if constexpr (GATHER) PG8_AOFF(wa_, ssel, 1);
            PG8_WAIT_V(8); PG8_WAIT_L(0); PG8_BAR; PG8_MMA(1, 0, At, B0); PG8_MMA(1, 1, At, B1); PG8_BAR; PG8_SCHED;
            PG8_LDB(B0, 1, 0); PG8_LDB(B1, 1, 1); PG8_SCHED; PG8_LDA(At, 1, 0); PG8_STAGE(PG8_SA(0, 1), rsrcA, a2 + hsA, wa_);
            if constexpr (GATHER) PG8_AOFF(wa_, ssel, 0);
            PG8_WAIT_V(8); PG8_WAIT_L(0); PG8_BAR; PG8_MMA(0, 0, At, B0); PG8_MMA(0, 1, At, B1); PG8_BAR; PG8_SCHED;
            PG8_LDA(At, 1, 1); PG8_STAGE(PG8_SB(1, 0), rsrcB, b3, voffB); PG8_STAGE(PG8_SB(1, 1), rsrcB, b3 + hstep, voffB); PG8_STAGE(PG8_SA(1, 0), rsrcA, a3, wa_);
            PG8_WAIT_V(8); PG8_WAIT_L(0); PG8_BAR; PG8_MMA(1, 0, At, B0); PG8_MMA(1, 1, At, B1); PG8_BAR; PG8_SCHED;
            } else {
            PG8_LDB(B0, 0, 0); PG8_SCHED; PG8_LDA(At, 0, 0); PG8_STAGE(PG8_SA(1, 1), rsrcA, a1 + hstep, voffA);
            PG8_WAIT_L(8); PG8_BAR; PG8_WAIT_L(0); PG8_MMA(0, 0, At, B0); PG8_BAR; PG8_SCHED;
            PG8_LDB(B1, 0, 1); PG8_STAGE(PG8_SB(0, 0), rsrcB, b2, voffB);
            PG8_BAR; PG8_WAIT_L(0); PG8_MMA(0, 1, At, B1); PG8_BAR;
            PG8_LDA(At, 0, 1); PG8_STAGE(PG8_SA(0, 0), rsrcA, a2, voffA);
            PG8_BAR; PG8_WAIT_L(0); PG8_MMA(1, 0, At, B0); PG8_BAR; PG8_SCHED;
            PG8_STAGE(PG8_SB(0, 1), rsrcB, b2 + hstep, voffB);
            PG8_WAIT_V(6); PG8_BAR; PG8_MMA(1, 1, At, B1); PG8_BAR;
            PG8_LDB(B0, 1, 0); PG8_SCHED; PG8_LDA(At, 1, 0); PG8_STAGE(PG8_SA(0, 1), rsrcA, a2 + hstep, voffA);
            PG8_WAIT_L(8); PG8_BAR; PG8_WAIT_L(0); PG8_MMA(0, 0, At, B0); PG8_BAR; PG8_SCHED;
            PG8_LDB(B1, 1, 1); PG8_STAGE(PG8_SB(1, 0), rsrcB, b3, voffB);
            PG8_BAR; PG8_WAIT_L(0); PG8_MMA(0, 1, At, B1); PG8_BAR;
            PG8_LDA(At, 1, 1); PG8_STAGE(PG8_SA(1, 0), rsrcA, a3, voffA);
            PG8_BAR; PG8_WAIT_L(0); PG8_MMA(1, 0, At, B0); PG8_BAR; PG8_SCHED;
            PG8_STAGE(PG8_SB(1, 1), rsrcB, b3 + hstep, voffB);
            PG8_WAIT_V(6); PG8_BAR; PG8_MMA(1, 1, At, B1); PG8_BAR;
            }
        }
        if constexpr (ALIGN_EPI) { if (wr == 0) PG8_BAR; }
        { const int lz = opaque_lane();
          E(acc, cur, wid >> 2, wid & 3, lz & 15, lz >> 4); }
        if (!has_next) break;
#pragma unroll
        for (int a = 0; a < 2; ++a)
#pragma unroll
            for (int b = 0; b < 2; ++b)
#pragma unroll
                for (int m = 0; m < 4; ++m)
#pragma unroll
                    for (int n = 0; n < 2; ++n) acc[a][b][m][n] = (f32x4){0.f, 0.f, 0.f, 0.f};
        cur = nxt; cA = nA; cB = nB; ++ui;
        if constexpr (ALIGN_EPI) { if (wr == 1) PG8_BAR; }
    }
    PG8_WAIT_V(0);
    if constexpr (!ALIGN_EPI) { if (wr == 0) PG8_BAR; }
    PG8_BAR;
#undef PG8_SA
#undef PG8_SB
#undef PG8_STAGE
#undef PG8_TOKDMA
#undef PG8_AOFF
#undef PG8_LDA
#undef PG8_LDB
#undef PG8_MMA
#undef PG8_HALF
#undef PG8_WAIT_V
#undef PG8_WAIT_L
#undef PG8_BAR
#undef PG8_SCHED
}

__device__ __forceinline__ void st8bf(bf16_t* p, const f32x4& v0, const f32x4& v1) {
    u32x4 o; o.x = cvt_pk_bf16(v0[0], v0[1]); o.y = cvt_pk_bf16(v0[2], v0[3]); o.z = cvt_pk_bf16(v1[0], v1[1]); o.w = cvt_pk_bf16(v1[2], v1[3]);
    *(u32x4*)p = o;
}

constexpr float QKV_SCALE = 32.f;
struct EpiQKV {
    bf16_t* Q; bf16_t* KC; bf16_t* VC; const float* rope;
    static constexpr float WSC = 1.f / QKV_SCALE;
    __device__ __forceinline__ void operator()(const f32x4 (&acc)[2][2][4][2], const Unit& u, int wr, int wc, int fr, int fq) const {
        const int pm = u.pm, pn = u.pn;
        const bool lat = pm < 128;
        const int b = lat ? (pm >> 5) : (pm - 128);
        const int posb = lat ? ((pm & 31) << 8) : 0;
        const size_t kvrow0 = (size_t)b * KVLEN + (lat ? (NCTX + posb) : 0);
        const size_t qrow0 = (size_t)pm * 256;
        if (pn < 8) {
            const int sec = pn >> 2;
            const int blk = 4 * (pn & 3) + wc;
            const float scl = sec == 0 ? QSCALE * WSC : WSC;
#pragma unroll
            for (int ai = 0; ai < 2; ++ai)
#pragma unroll
                for (int m = 0; m < 4; ++m) {
                    const int lr = 128 * ai + 64 * wr + 16 * m + fr;
                    f32x4 cs0 = {1.f, 0.f, 1.f, 0.f}, cs1 = cs0, cs2 = cs0, cs3 = cs0;
                    if (lat) { const int pos = posb + lr; const int v = (fq < 2) ? (pos >> 6) : (pos & 63);
                        const f32x4* rp = (const f32x4*)(rope + (size_t)(v * 16 + (fq & 1) * 8) * 2);
                        cs0 = rp[0]; cs1 = rp[1]; cs2 = rp[2]; cs3 = rp[3]; }
                    const f32x4 a0 = acc[ai][0][m][0], a1 = acc[ai][0][m][1], b0 = acc[ai][1][m][0], b1 = acc[ai][1][m][1];
                    f32x4 o1a, o1b, o2a, o2b;
                    o1a[0] = (a0[0] * cs0[0] - b0[0] * cs0[1]) * scl; o2a[0] = (a0[0] * cs0[1] + b0[0] * cs0[0]) * scl;
                    o1a[1] = (a0[1] * cs0[2] - b0[1] * cs0[3]) * scl; o2a[1] = (a0[1] * cs0[3] + b0[1] * cs0[2]) * scl;
                    o1a[2] = (a0[2] * cs1[0] - b0[2] * cs1[1]) * scl; o2a[2] = (a0[2] * cs1[1] + b0[2] * cs1[0]) * scl;
                    o1a[3] = (a0[3] * cs1[2] - b0[3] * cs1[3]) * scl; o2a[3] = (a0[3] * cs1[3] + b0[3] * cs1[2]) * scl;
                    o1b[0] = (a1[0] * cs2[0] - b1[0] * cs2[1]) * scl; o2b[0] = (a1[0] * cs2[1] + b1[0] * cs2[0]) * scl;
                    o1b[1] = (a1[1] * cs2[2] - b1[1] * cs2[3]) * scl; o2b[1] = (a1[1] * cs2[3] + b1[1] * cs2[2]) * scl;
                    o1b[2] = (a1[2] * cs3[0] - b1[2] * cs3[1]) * scl; o2b[2] = (a1[2] * cs3[1] + b1[2] * cs3[0]) * scl;
                    o1b[3] = (a1[3] * cs3[2] - b1[3] * cs3[3]) * scl; o2b[3] = (a1[3] * cs3[3] + b1[3] * cs3[2]) * scl;
                    bf16_t* rowp = (sec == 0 ? Q + (qrow0 + lr) * DM : KC + (kvrow0 + lr) * DM) + 64 * blk + 8 * fq;
                    st8bf(rowp, o1a, o1b); st8bf(rowp + 32, o2a, o2b);
                }
        } else {
            const int col0 = 256 * (pn - 8) + 32 * wc + 8 * fq;
#pragma unroll
            for (int ai = 0; ai < 2; ++ai)
#pragma unroll
                for (int m = 0; m < 4; ++m) {
                    const int lr = 128 * ai + 64 * wr + 16 * m + fr;
                    bf16_t* rowp = VC + (kvrow0 + lr) * DM + col0;
                    st8bf(rowp, acc[ai][0][m][0] * WSC, acc[ai][0][m][1] * WSC); st8bf(rowp + 128, acc[ai][1][m][0] * WSC, acc[ai][1][m][1] * WSC);
                }
        }
    }
};
struct EpiPlain {
    bf16_t* O;
    __device__ __forceinline__ void operator()(const f32x4 (&acc)[2][2][4][2], const Unit& u, int wr, int wc, int fr, int fq) const {
        const int col0 = 256 * u.pn + 32 * wc + 8 * fq;
#pragma unroll
        for (int ai = 0; ai < 2; ++ai)
#pragma unroll
            for (int m = 0; m < 4; ++m) {
                bf16_t* rowp = O + ((size_t)u.pm * 256 + 128 * ai + 64 * wr + 16 * m + fr) * DM + col0;
                st8bf(rowp, acc[ai][0][m][0], acc[ai][0][m][1]); st8bf(rowp + 128, acc[ai][1][m][0], acc[ai][1][m][1]);
            }
    }
};
struct EpiGlaIn {
    bf16_t* Gq; bf16_t* Gk; bf16_t* Gv; bf16_t* Gr; float* Gz;
    __device__ __forceinline__ void operator()(const f32x4 (&acc)[2][2][4][2], const Unit& u, int wr, int wc, int fr, int fq) const {
        const int pn = u.pn;
        const size_t row0 = (size_t)u.pm * 256;
        if (pn == 12) {
            if (wc == 0) {
#pragma unroll
                for (int ai = 0; ai < 2; ++ai)
#pragma unroll
                    for (int m = 0; m < 4; ++m) {
                        float* rowp = Gz + (row0 + 128 * ai + 64 * wr + 16 * m + fr) * 32 + 8 * fq;
                        *(f32x4*)rowp = acc[ai][0][m][0]; *(f32x4*)(rowp + 4) = acc[ai][0][m][1];
                    }
            }
            return;
        }
        bf16_t* base; int ld, ct; float scl = 1.f;
        if (pn < 2) { base = Gq; ld = 512; ct = pn; scl = 0.08838834764831845f; }
        else if (pn < 4) { base = Gk; ld = 512; ct = pn - 2; }
        else if (pn < 8) { base = Gv; ld = 1024; ct = pn - 4; }
        else { base = Gr; ld = 1024; ct = pn - 8; }
        const int col0 = 256 * ct + 32 * wc + 8 * fq;
#pragma unroll
        for (int ai = 0; ai < 2; ++ai)
#pragma unroll
            for (int m = 0; m < 4; ++m) {
                bf16_t* rowp = base + (row0 + 128 * ai + 64 * wr + 16 * m + fr) * ld + col0;
                st8bf(rowp, acc[ai][0][m][0] * scl, acc[ai][0][m][1] * scl); st8bf(rowp + 128, acc[ai][1][m][0] * scl, acc[ai][1][m][1] * scl);
            }
    }
};
__device__ __forceinline__ unsigned pk4_fp8(float a, float b, float c, float d) { int w = 0; w = __builtin_amdgcn_cvt_pk_fp8_f32(a, b, w, false); w = __builtin_amdgcn_cvt_pk_fp8_f32(c, d, w, true); return (unsigned)w; }
constexpr float WGU_SCALE = 32.f, WD_SCALE = 64.f, H_SCALE = 8.f, Y_SCALE = 16.f;
struct EpiGateUp {
    unsigned char* ws; const unsigned char* lds; int layer;
    __device__ __forceinline__ void operator()(const f32x4 (&acc)[2][2][4][2], const Unit& u, int wr, int wc, int fr, int fq) const {
        unsigned char* H = ws + WS_H; const float* bgu = INP(I_BGU) + (size_t)layer * 32 * 2048;
        const int xc = 128 * u.pn + 32 * wc + 8 * fq;
        const float* bp = bgu + (size_t)u.e * 2048 + xc;
        const f32x4 bg0 = *(const f32x4*)bp, bg1 = *(const f32x4*)(bp + 4), bl0 = *(const f32x4*)(bp + 1024), bl1 = *(const f32x4*)(bp + 1028);
        constexpr float ws = 1.f / WGU_SCALE;
#pragma unroll
        for (int ai = 0; ai < 2; ++ai)
#pragma unroll
            for (int m = 0; m < 4; ++m) {
                f32x4 o0, o1;
#pragma unroll
                for (int i = 0; i < 4; ++i) {
                    float g = fminf(acc[ai][0][m][0][i] * ws + bg0[i], 7.f), l = fminf(fmaxf(acc[ai][1][m][0][i] * ws + bl0[i], -7.f), 7.f);
                    o0[i] = H_SCALE * g * __builtin_amdgcn_rcpf(1.f + __expf(-1.702f * g)) * (l + 1.f);
                    g = fminf(acc[ai][0][m][1][i] * ws + bg1[i], 7.f); l = fminf(fmaxf(acc[ai][1][m][1][i] * ws + bl1[i], -7.f), 7.f);
                    o1[i] = H_SCALE * g * __builtin_amdgcn_rcpf(1.f + __expf(-1.702f * g)) * (l + 1.f);
                }
                u32x2 o; o.x = pk4_fp8(o0[0], o0[1], o0[2], o0[3]); o.y = pk4_fp8(o1[0], o1[1], o1[2], o1[3]);
                *(u32x2*)(H + ((size_t)u.pm * 256 + 128 * ai + 64 * wr + 16 * m + fr) * DM + xc) = o;
            }
    }
};
struct EpiDown {
    unsigned char* ws; const unsigned char* lds; int layer;
    __device__ __forceinline__ void operator()(const f32x4 (&acc)[2][2][4][2], const Unit& u, int wr, int wc, int fr, int fq) const {
        unsigned char* YD = ws + WS_XS; const float* bd = INP(I_BD) + (size_t)layer * 32 * 1024;
        const int col0 = 256 * u.pn + 32 * wc + 8 * fq;
        const float* bp = bd + (size_t)u.e * 1024 + col0;
        const f32x4 b00 = *(const f32x4*)bp, b01 = *(const f32x4*)(bp + 4), b10 = *(const f32x4*)(bp + 128), b11 = *(const f32x4*)(bp + 132);
        constexpr float ws_ = Y_SCALE / (WD_SCALE * H_SCALE);
#pragma unroll
        for (int ai = 0; ai < 2; ++ai)
#pragma unroll
            for (int m = 0; m < 4; ++m) {
                unsigned char* rowp = YD + ((size_t)u.pm * 256 + 128 * ai + 64 * wr + 16 * m + fr) * DM + col0;
                const f32x4 v0 = acc[ai][0][m][0] * ws_ + b00 * Y_SCALE, v1 = acc[ai][0][m][1] * ws_ + b01 * Y_SCALE, v2 = acc[ai][1][m][0] * ws_ + b10 * Y_SCALE, v3 = acc[ai][1][m][1] * ws_ + b11 * Y_SCALE;
                u32x2 o0, o1; o0.x = pk4_fp8(v0[0], v0[1], v0[2], v0[3]); o0.y = pk4_fp8(v1[0], v1[1], v1[2], v1[3]); o1.x = pk4_fp8(v2[0], v2[1], v2[2], v2[3]); o1.y = pk4_fp8(v3[0], v3[1], v3[2], v3[3]);
                *(u32x2*)rowp = o0; *(u32x2*)(rowp + 128) = o1;
            }
    }
};
}

namespace att {
constexpr int NW = 8, QBLK = 32, KVBLK = 64;
constexpr size_t SHM_V = KVBLK * 128 * 2, SHM_K = KVBLK * 128 * 2;

constexpr float THR = 8.f;
#define KSWZ(row, colB) ((row) * 256 + ((colB) ^ (((row) & 15) << 4)))
__device__ __forceinline__ int v_st(int k, int c) { const int kk = (k & ~0xC) | ((k & 4) << 1) | ((k & 8) >> 1); return ((kk >> 3) * 4 + (c >> 5)) * 512 + ((kk & 7) * 32 + (c & 31)) * 2; }
__device__ __forceinline__ int v_rd_base(int lane) { return ((lane & 3) << 3) | (((lane >> 2) & 3) << 6) | (((lane >> 4) & 1) << 5) | (((lane >> 5) & 1) << 8); }
constexpr int v_rd_off(int d0, int ks, int half) { return d0 * 512 + ks * 4096 + half * 2048; }
template <int OFF> __device__ __forceinline__ s16x4 tr_read(int vb) {
    s16x4 r; asm volatile("ds_read_b64_tr_b16 %0, %1 offset:%2" : "=&v"(r) : "v"(vb), "i"(OFF) : "memory"); return r;
}
__device__ __forceinline__ void qkt_map(f32x16& p0, f32x16& p1, const char* Ks, const bf16x8* qs  , int mapB, int r32, int hi) {
    p0 = f32x16{}; p1 = f32x16{};
#pragma unroll
    for (int d0 = 0; d0 < 4; ++d0) { const int cb = mapB + (d0 * 16 + hi * 8) * 2;
        const bf16x8 b0 = *reinterpret_cast<const bf16x8*>(Ks + KSWZ(r32, cb));
        const bf16x8 b1 = *reinterpret_cast<const bf16x8*>(Ks + KSWZ(32 + r32, cb));
        const bf16x8 q = qs[d0 * 64];
        p0 = __builtin_amdgcn_mfma_f32_32x32x16_bf16(b0, q, p0, 0, 0, 0);
        p1 = __builtin_amdgcn_mfma_f32_32x32x16_bf16(b1, q, p1, 0, 0, 0); }
}
__device__ __forceinline__ void softmax_tile(f32x16& p0, f32x16& p1, float& m_reg, float& l_reg, float& alpha, bf16x8& pa0, bf16x8& pa1, bf16x8& pa2, bf16x8& pa3) {
    float pmax = p0[0];
#pragma unroll
    for (int r = 1; r < 16; ++r) pmax = fmaxf(pmax, p0[r]);
#pragma unroll
    for (int r = 0; r < 16; ++r) pmax = fmaxf(pmax, p1[r]);
    { auto rr = __builtin_amdgcn_permlane32_swap(__float_as_uint(pmax), __float_as_uint(pmax), false, false);
      pmax = fmaxf(__uint_as_float(rr[0]), __uint_as_float(rr[1])); }
    float mn;
    if (__builtin_expect(__all(pmax - m_reg <= THR), 1)) { mn = m_reg; alpha = 1.f; }
    else { mn = fmaxf(m_reg, pmax); alpha = __builtin_amdgcn_exp2f(m_reg - mn); m_reg = mn; }
#pragma unroll
    for (int r = 0; r < 16; ++r) p0[r] = __builtin_amdgcn_exp2f(p0[r] - mn);
#pragma unroll
    for (int r = 0; r < 16; ++r) p1[r] = __builtin_amdgcn_exp2f(p1[r] - mn);
    float ps = 0.f;
#pragma unroll
    for (int r = 0; r < 16; ++r) ps += p0[r];
#pragma unroll
    for (int r = 0; r < 16; ++r) ps += p1[r];
    { auto rr = __builtin_amdgcn_permlane32_swap(__float_as_uint(ps), __float_as_uint(ps), false, false);
      ps = __uint_as_float(rr[0]) + __uint_as_float(rr[1]); }
    l_reg = l_reg * alpha + ps;
#define PK4(P, BASE, OUT) do { unsigned a0 = cvt_pk_bf16(P[BASE + 0], P[BASE + 1]), a1 = cvt_pk_bf16(P[BASE + 2], P[BASE + 3]);   \
    unsigned b0 = cvt_pk_bf16(P[BASE + 4], P[BASE + 5]), b1 = cvt_pk_bf16(P[BASE + 6], P[BASE + 7]);                              \
    auto r0 = __builtin_amdgcn_permlane32_swap(a0, b0, false, false); auto r1 = __builtin_amdgcn_permlane32_swap(a1, b1, false, false); \
    u32x4 w = {r0[0], r1[0], r0[1], r1[1]}; OUT = *reinterpret_cast<bf16x8*>(&w); } while (0)
    PK4(p0, 0, pa0); PK4(p0, 8, pa1); PK4(p1, 0, pa2); PK4(p1, 8, pa3);
#undef PK4
}
template <int BASE> __device__ __forceinline__ void pk4_frag(const f32x16& P, bf16x8& out) {
    const unsigned a0 = cvt_pk_bf16(P[BASE + 0], P[BASE + 1]), a1 = cvt_pk_bf16(P[BASE + 2], P[BASE + 3]), b0 = cvt_pk_bf16(P[BASE + 4], P[BASE + 5]), b1 = cvt_pk_bf16(P[BASE + 6], P[BASE + 7]);
    auto r0 = __builtin_amdgcn_permlane32_swap(a0, b0, false, false); auto r1 = __builtin_amdgcn_permlane32_swap(a1, b1, false, false);
    u32x4 w = {r0[0], r1[0], r0[1], r1[1]}; out = *reinterpret_cast<bf16x8*>(&w);
}
template <int D0> __device__ __forceinline__ void pv_both(f32x16& oa, f32x16& ob, int vb, const bf16x8 (&pa)[4], const bf16x8 (&pb)[4]) {
    const s16x4 l0 = tr_read<v_rd_off(D0, 0, 0)>(vb), h0 = tr_read<v_rd_off(D0, 0, 1)>(vb), l1 = tr_read<v_rd_off(D0, 1, 0)>(vb), h1 = tr_read<v_rd_off(D0, 1, 1)>(vb);
    const s16x4 l2 = tr_read<v_rd_off(D0, 2, 0)>(vb), h2 = tr_read<v_rd_off(D0, 2, 1)>(vb), l3 = tr_read<v_rd_off(D0, 3, 0)>(vb), h3 = tr_read<v_rd_off(D0, 3, 1)>(vb);
    asm volatile("s_waitcnt lgkmcnt(0)" ::: "memory"); SBAR();
#define PK(L, H) (bf16x8){L[0], L[1], L[2], L[3], H[0], H[1], H[2], H[3]}
    const bf16x8 v0 = PK(l0, h0), v1 = PK(l1, h1), v2 = PK(l2, h2), v3 = PK(l3, h3);
    oa = __builtin_amdgcn_mfma_f32_32x32x16_bf16(pa[0], v0, oa, 0, 0, 0);
    ob = __builtin_amdgcn_mfma_f32_32x32x16_bf16(pb[0], v0, ob, 0, 0, 0);
    oa = __builtin_amdgcn_mfma_f32_32x32x16_bf16(pa[1], v1, oa, 0, 0, 0);
    ob = __builtin_amdgcn_mfma_f32_32x32x16_bf16(pb[1], v1, ob, 0, 0, 0);
    oa = __builtin_amdgcn_mfma_f32_32x32x16_bf16(pa[2], v2, oa, 0, 0, 0);
    ob = __builtin_amdgcn_mfma_f32_32x32x16_bf16(pb[2], v2, ob, 0, 0, 0);
    oa = __builtin_amdgcn_mfma_f32_32x32x16_bf16(pa[3], v3, oa, 0, 0, 0);
    ob = __builtin_amdgcn_mfma_f32_32x32x16_bf16(pb[3], v3, ob, 0, 0, 0);
#undef PK
}
template <int VAR>
__device__ __forceinline__ void attn_unit(const bf16_t* __restrict__ Qb, const bf16_t* __restrict__ Kh, const bf16_t* __restrict__ Vh, bf16_t* __restrict__ Ob,
                                          int nkeys, float lam, const float* __restrict__ subw, char* lds, const int wid) {
    int lane = (int)__lane_id(); asm volatile("" : "+v"(lane));
    const int r32 = lane & 31, hi = lane >> 5;
    char* V_lds = lds; char* K_lds = lds + 2 * SHM_V;
    float* ws = (float*)(lds + LDS_MISC + 256) + wid * 128;
    float m0 = -1e30f, l0 = 0.f, m1 = -1e30f, l1 = 0.f;
    f32x16 oa[4] = {}, ob[4] = {};
    bf16x8* qs = (bf16x8*)(lds + 2 * SHM_V + 3 * SHM_K + wid * 8192) + lane;
    { const bf16_t* Qw = Qb + (size_t)(wid * QBLK + r32) * DM + hi * 8;
#pragma unroll
      for (int d0 = 0; d0 < 8; ++d0) qs[d0 * 64] = *reinterpret_cast<const bf16x8*>(Qw + d0 * 16); }
    const int vb0 = (int)(uintptr_t)V_lds + v_rd_base(lane);
    LAS unsigned char* ldsK = (LAS unsigned char*)K_lds + wid * 1024; LAS unsigned char* ldsV = (LAS unsigned char*)V_lds + wid * 1024;
    const __amdgpu_buffer_rsrc_t rsrcK = __builtin_amdgcn_make_buffer_rsrc((void*)Kh, 0, 0x7fffffff, 0x00020000), rsrcV = __builtin_amdgcn_make_buffer_rsrc((void*)Vh, 0, 0x7fffffff, 0x00020000);
    int goffK[2], goffV[2];
#pragma unroll
    for (int i = 0; i < 2; ++i) { const int p = wid + 8 * i;
        const int krow = 4 * p + (lane >> 4), kch = (lane & 15) ^ (krow & 15);
        goffK[i] = (krow * DM + kch * 8) * 2;
        const int within = lane & 31, kk = 8 * (p >> 1) + (within >> 2), k = (kk & ~0xC) | ((kk & 4) << 1) | ((kk & 8) >> 1), c = 32 * (2 * (p & 1) + (lane >> 5)) + 8 * (within & 3);
        goffV[i] = (k * DM + c) * 2; }
#define DMA_K(t, b) do { if constexpr ((VAR & 8) != 0) break; const int so_ = (t) * (KVBLK * DM * 2); \
    _Pragma("unroll") for (int _i = 0; _i < 2; ++_i) __builtin_amdgcn_raw_ptr_buffer_load_lds(rsrcK, (LAS void*)(ldsK + (b) * SHM_K + _i * 8192), 16, goffK[_i], so_, 0, 0); } while (0)
#define DMA_V(t, b) do { if constexpr ((VAR & 8) != 0) break; const int so_ = (t) * (KVBLK * DM * 2); \
    _Pragma("unroll") for (int _i = 0; _i < 2; ++_i) __builtin_amdgcn_raw_ptr_buffer_load_lds(rsrcV, (LAS void*)(ldsV + (b) * SHM_V + _i * 8192), 16, goffV[_i], so_, 0, 0); } while (0)
#define WAIT_BAR(N) do { if constexpr ((VAR & 16) != 0) { asm volatile("s_waitcnt vmcnt(" #N ") lgkmcnt(0)" ::: "memory"); } else { asm volatile("s_waitcnt vmcnt(" #N ") lgkmcnt(0)\n\ts_barrier" ::: "memory"); } } while (0)
#define RESC(o, a) do { if (__any((a) < 1.f)) { if (hi == 0) ws[r32] = (a); LDS_WAIT(); \
    _Pragma("unroll") for (int d = 0; d < 4; ++d) _Pragma("unroll") for (int r = 0; r < 16; ++r) o[d][r] *= ws[crow(r, hi)]; } } while (0)
    const int NT = nkeys / KVBLK;
    const int half = wid >> 2;
    DMA_K(0, 0); DMA_V(0, 0);
    WAIT_BAR(0);
#define QKT_V(p0, p1, Kt, q, mb) do { if constexpr ((VAR & 1) != 0) { _Pragma("unroll") for (int r_ = 0; r_ < 16; ++r_) { p0[r_] = 0.01f * (float)(r_ + r32); p1[r_] = 0.02f * (float)(r_ + hi); } } else qkt_map(p0, p1, Kt, q, mb, r32, hi); } while (0)
#define SM_V(p0, p1, m, l, al, f0, f1, f2, f3) do { if constexpr ((VAR & 2) != 0) { al = 1.f; pk4_frag<0>(p0, f0); pk4_frag<8>(p0, f1); pk4_frag<0>(p1, f2); pk4_frag<8>(p1, f3); l += p0[0]; } else softmax_tile(p0, p1, m, l, al, f0, f1, f2, f3); } while (0)
#define STEP_H1(b) do { const char* Kt = K_lds + (b) * SHM_K; f32x16 p0, p1, q0, q1; float al; \
        QKT_V(p0, p1, Kt, qs, 0); QKT_V(q0, q1, Kt, qs + 256, 128);          \
        SM_V(p0, p1, m0, l0, al, pa[0], pa[1], pa[2], pa[3]); RESC(oa, al); \
        SM_V(q0, q1, m1, l1, al, pb[0], pb[1], pb[2], pb[3]); RESC(ob, al); } while (0)
#define STEP_H2(b) do { const int vb = vb0 + (b) * (int)SHM_V; \
        if constexpr ((VAR & 4) != 0) { oa[0][0] += __builtin_bit_cast(float, (int)pa[0][0] + (int)pb[1][1] + vb); } else { \
        pv_both<0>(oa[0], ob[0], vb, pa, pb); pv_both<1>(oa[1], ob[1], vb, pa, pb); pv_both<2>(oa[2], ob[2], vb, pa, pb); pv_both<3>(oa[3], ob[3], vb, pa, pb); } } while (0)
#define STEP_X(kb) do { const char* Kt = K_lds + (kb) * SHM_K; f32x16 p0, p1; float al; \
        QKT_V(p0, p1, Kt, qs, 0); SM_V(p0, p1, m0, l0, al, pa[0], pa[1], pa[2], pa[3]); RESC(oa, al); } while (0)
#define STEP_Y(kb, b) do { const char* Kt = K_lds + (kb) * SHM_K; f32x16 p0, p1; float al; \
        QKT_V(p0, p1, Kt, qs + 256, 128); SM_V(p0, p1, m1, l1, al, pb[0], pb[1], pb[2], pb[3]); RESC(ob, al); STEP_H2(b); } while (0)
#ifndef ATT_STAGGER
#define ATT_STAGGER 0
#endif
    if (!ATT_STAGGER) {
        (void)half;
        for (int j = 0; j < NT; ++j) {
            const int b = j & 1; bf16x8 pa[4], pb[4];
            if (j + 1 < NT) { DMA_K(j + 1, b ^ 1); DMA_V(j + 1, b ^ 1); }
            STEP_H1(b);
            STEP_H2(b);
            WAIT_BAR(0);
        }
    } else if (half == 0) {
        int kb = 0;
        for (int j = 0; j < NT; ++j) {
            const int b = j & 1, kbn = kb == 2 ? 0 : kb + 1; bf16x8 pa[4], pb[4];
            const bool more = j + 1 < NT;
            if (more) DMA_K(j + 1, kbn);
            STEP_X(kb);
            if (more) WAIT_BAR(2); else WAIT_BAR(0);
            if (more) DMA_V(j + 1, b ^ 1);
            STEP_Y(kb, b);
            if (more) WAIT_BAR(2); else WAIT_BAR(0);
            kb = kbn;
        }
        WAIT_BAR(0);
    } else {
        if (NT > 1) { DMA_K(1, 1); WAIT_BAR(2); } else WAIT_BAR(0);
        int kb = 0;
        for (int j = 0; j < NT; ++j) {
            const int b = j & 1, kbn = kb == 2 ? 0 : kb + 1, kbnn = kbn == 2 ? 0 : kbn + 1; bf16x8 pa[4], pb[4];
            if (j + 1 < NT) DMA_V(j + 1, b ^ 1);
            STEP_X(kb);
            if (j + 1 < NT) WAIT_BAR(2); else WAIT_BAR(0);
            if (j + 2 < NT) DMA_K(j + 2, kbnn);
            STEP_Y(kb, b);
            if (j + 2 < NT) WAIT_BAR(2); else WAIT_BAR(0);
            kb = kbn;
        }
    }
#undef STEP_X
#undef STEP_Y
#undef STEP_H1
#undef STEP_H2
#undef QKT_V
#undef SM_V
    if (hi == 0) { ws[r32] = l0; ws[32 + r32] = l1; }
    int lane_e = lane; asm volatile("" : "+v"(lane_e));
    const int r32e = lane_e & 31, hie = lane_e >> 5;
    LDS_WAIT();
    float ss[16];
#pragma unroll
    for (int r = 0; r < 16; ++r) { const float ra = __builtin_amdgcn_rcpf(ws[crow(r, hi)]), rb = lam * __builtin_amdgcn_rcpf(ws[32 + crow(r, hi)]);
        float s = 0.f;
#pragma unroll
        for (int d = 0; d < 4; ++d) { const float v = oa[d][r] * ra - ob[d][r] * rb; oa[d][r] = v; s += v * v; }
        ss[r] = s; }
#pragma unroll
    for (int r = 0; r < 16; ++r) {
        ss[r] = rsqrtf(half32_sum(ss[r]) * (1.f / 128.f) + NORM_EPS) * (1.f - LAM_INIT0);
    }
    float wv[4];
#pragma unroll
    for (int d = 0; d < 4; ++d) wv[d] = subw[d * 32 + r32e];
    bf16_t* Ow = Ob + (size_t)(wid * QBLK) * DM;
#pragma unroll
    for (int r = 0; r < 16; ++r) { const int orow = crow(r, hie);
#pragma unroll
        for (int d = 0; d < 4; ++d) Ow[(size_t)orow * DM + d * 32 + r32e] = (bf16_t)(cvt_pk_bf16(oa[d][r] * ss[r] * wv[d], 0.f) & 0xffffu); }
    __syncthreads();
#undef DMA_K
#undef DMA_V
#undef WAIT_BAR
#undef RESC
}

struct SmState { float m, l, mn, al, a, b, c, d; unsigned negm; bool upd; };
template <int C> __device__ __forceinline__ float max8(const f32x16& P0, const f32x16& P1) {
    constexpr int B = (C & 1) * 8;
    if constexpr (C < 2) { float a = fmaxf(fmaxf(P0[B], P0[B + 1]), P0[B + 2]); a = fmaxf(fmaxf(a, P0[B + 3]), P0[B + 4]); a = fmaxf(fmaxf(a, P0[B + 5]), P0[B + 6]); return fmaxf(a, P0[B + 7]); }
    else { float a = fmaxf(fmaxf(P1[B], P1[B + 1]), P1[B + 2]); a = fmaxf(fmaxf(a, P1[B + 3]), P1[B + 4]); a = fmaxf(fmaxf(a, P1[B + 5]), P1[B + 6]); return fmaxf(a, P1[B + 7]); }
}
__device__ __forceinline__ float vadd(float a, float b) { float r = a + b; asm volatile("" : "+v"(r)); return r; }
template <int C> __device__ __forceinline__ float sum8(const f32x16& P0, const f32x16& P1) {
    constexpr int B = (C & 1) * 8;
    const f32x16& P = C < 2 ? P0 : P1;
    const float t0 = vadd(P[B], P[B + 1]), t1 = vadd(P[B + 2], P[B + 3]), t2 = vadd(P[B + 4], P[B + 5]), t3 = vadd(P[B + 6], P[B + 7]);
    const float u0 = vadd(t0, t1), u1 = vadd(t2, t3);
    return vadd(u0, u1);
}
template <int E, bool SUB> __device__ __forceinline__ void exp_at(f32x16& P0, f32x16& P1, float mn) {
    if constexpr (E < 16) { P0[E] = __builtin_amdgcn_exp2f(SUB ? P0[E] - mn : P0[E]); asm volatile("" : "+v"(P0[E])); }
    else if constexpr (E < 32) { P1[E - 16] = __builtin_amdgcn_exp2f(SUB ? P1[E - 16] - mn : P1[E - 16]); asm volatile("" : "+v"(P1[E - 16])); }
}
#ifndef ATT_SUMTHR
#define ATT_SUMTHR 1.8446744e19f
#endif
constexpr float SUMTHR = ATT_SUMTHR, SUMLOW = 5.4e-20f;
template <int G> __device__ __forceinline__ void sm1_chunk(f32x16& P0, f32x16& P1) { exp_at<2 * G, false>(P0, P1, 0.f); exp_at<2 * G + 1, false>(P0, P1, 0.f); }
template <int G> __device__ __forceinline__ void sm2_chunk(f32x16& P0, f32x16& P1, SmState& s, bf16x8 (&f)[4], f32x16 (&o)[4], float* ws) {
    if constexpr (G == 0) s.a = sum8<0>(P0, P1);
    else if constexpr (G == 1) s.b = sum8<1>(P0, P1);
    else if constexpr (G == 2) s.c = sum8<2>(P0, P1);
    else if constexpr (G == 3) { float ps = (s.a + s.b) + (s.c + sum8<3>(P0, P1));
        { auto rr = __builtin_amdgcn_permlane32_swap(__float_as_uint(ps), __float_as_uint(ps), false, false); ps = __uint_as_float(rr[0]) + __uint_as_float(rr[1]); }
        const float ln = s.l + ps;
        if (__builtin_expect(__all(ps <= SUMTHR && ln >= SUMLOW), 1)) s.l = ln;
        else {
            float em = fmaxf(max8<0>(P0, P1), max8<1>(P0, P1)); em = fmaxf(em, fmaxf(max8<2>(P0, P1), max8<3>(P0, P1)));
            { auto rr = __builtin_amdgcn_permlane32_swap(__float_as_uint(em), __float_as_uint(em), false, false); em = fmaxf(__uint_as_float(rr[0]), __uint_as_float(rr[1])); }
            const float pmax = __builtin_amdgcn_logf(fmaxf(em, 1e-37f));
            const float mnew = s.m + (ln < SUMLOW ? pmax : fmaxf(pmax, 0.f));
            const unsigned hp = cvt_pk_bf16(mnew, 0.f) & 0xffffu; const float mh = bflo(hp);
            const unsigned lp = cvt_pk_bf16(mnew - mh, 0.f) & 0xffffu; const float mt = mh + bflo(lp);
            const float al = __builtin_amdgcn_exp2f(s.m - mt); s.m = mt;
            const int ln_ = opaque_lane(), r32_ = ln_ & 31, hi_ = ln_ >> 5;
            s.negm = hi_ == 0 ? ((hp | (lp << 16)) ^ 0x80008000u) : 0u;
#pragma unroll
            for (int r = 0; r < 16; ++r) { P0[r] *= al; P1[r] *= al; }
            s.l = s.l * al + ps * al; s.upd = true;
            if (__any(al != 1.f)) { if (hi_ == 0) ws[r32_] = al; LDS_WAIT();
#pragma unroll
                for (int d = 0; d < 4; ++d)
#pragma unroll
                    for (int r = 0; r < 16; ++r) o[d][r] *= ws[crow(r, hi_)]; } } }
    else if constexpr (G == 4) pk4_frag<0>(P0, f[0]);
    else if constexpr (G == 5) pk4_frag<8>(P0, f[1]);
    else if constexpr (G == 6) pk4_frag<0>(P1, f[2]);
    else pk4_frag<8>(P1, f[3]);
}
#define MF32(A_, B_, C_) __builtin_amdgcn_mfma_f32_32x32x16_bf16(A_, B_, C_, 0, 0, 0)
__device__ __forceinline__ void attn_unit_pipe(const bf16_t* __restrict__ Qb, const bf16_t* __restrict__ Kh, const bf16_t* __restrict__ Vh, bf16_t* __restrict__ Ob,
                                               int nkeys, float lam, const float* __restrict__ subw, char* lds, const int wid) {
    const int lane = opaque_lane();
    const int r32 = lane & 31, hi = lane >> 5;
    char* V_lds = lds; char* K_lds = lds + 2 * SHM_V;
    float* ws = (float*)(lds + LDS_MISC + 256) + wid * 128;
    SmState st0, st1; st0.m = 0.f; st0.l = 0.f; st0.mn = 0.f; st0.al = 1.f; st0.negm = 0u; st0.upd = false; st0.a = st0.b = st0.c = st0.d = 0.f; st1 = st0;
    f32x16 oa[4] = {}, ob[4] = {};
    bf16x8* qs = (bf16x8*)(lds + 2 * SHM_V + 3 * SHM_K + wid * 8192) + lane;
    { const bf16_t* Qw = Qb + (size_t)(wid * QBLK + r32) * DM + hi * 8;
#pragma unroll
      for (int d0 = 0; d0 < 8; ++d0) qs[d0 * 64] = *reinterpret_cast<const bf16x8*>(Qw + d0 * 16); }
    const int vb0 = (int)(uintptr_t)V_lds + v_rd_base(lane);
    LAS unsigned char* ldsK = (LAS unsigned char*)K_lds + wid * 1024; LAS unsigned char* ldsV = (LAS unsigned char*)V_lds + wid * 1024;
    const __amdgpu_buffer_rsrc_t rsrcK = __builtin_amdgcn_make_buffer_rsrc((void*)Kh, 0, 0x7fffffff, 0x00020000), rsrcV = __builtin_amdgcn_make_buffer_rsrc((void*)Vh, 0, 0x7fffffff, 0x00020000);
    int goffK, goffV;
    { const int p = wid;
      const int krow = 4 * p + (lane >> 4), kch = (lane & 15) ^ (krow & 15);
      goffK = (krow * DM + kch * 8) * 2;
      const int within = lane & 31, kk = 8 * (p >> 1) + (within >> 2), k = (kk & ~0xC) | ((kk & 4) << 1) | ((kk & 8) >> 1), c = 32 * (2 * (p & 1) + (lane >> 5)) + 8 * (within & 3);
      goffV = (k * DM + c) * 2; }
#define PDMA_K(t, b) do { const int so_ = (t) * (KVBLK * DM * 2); \
    _Pragma("unroll") for (int _i = 0; _i < 2; ++_i) __builtin_amdgcn_raw_ptr_buffer_load_lds(rsrcK, (LAS void*)(ldsK + (b) * SHM_K + _i * 8192), 16, goffK, so_ + _i * (32 * DM * 2), 0, 0); } while (0)
#define PDMA_V(t, b) do { const int so_ = (t) * (KVBLK * DM * 2); \
    _Pragma("unroll") for (int _i = 0; _i < 2; ++_i) __builtin_amdgcn_raw_ptr_buffer_load_lds(rsrcV, (LAS void*)(ldsV + (b) * SHM_V + _i * 8192), 16, goffV, so_ + _i * (32 * DM * 2), 0, 0); } while (0)
#define PWAIT_BAR() asm volatile("s_waitcnt vmcnt(0) lgkmcnt(0)\n\ts_barrier" ::: "memory")
    const int z0 = ((int)(uintptr_t)K_lds + r32 * 256) ^ ((r32 & 15) << 4) ^ (hi << 4);
#define KL0(D0, Kt_, MB_) (*(const LAS bf16x8*)(uintptr_t)(unsigned)((Kt_) ^ ((MB_) + (D0) * 32)))
#define KL1(D0, Kt_, MB_) (*(const LAS bf16x8*)(uintptr_t)(unsigned)(((Kt_) ^ ((MB_) + (D0) * 32)) + 8192))
#define QK_SEG(P0, P1, Kt_, QS_, MB_, NEGM_, CH, REF_) do { bf16x8 kb0_, kb1_, kqa_, kqb_; const f32x16 z_ = {}; \
        kb0_ = KL0(0, Kt_, MB_); kqa_ = (QS_)[0]; kb1_ = KL1(0, Kt_, MB_); SBAR(); \
        P0 = MF32(kb0_, kqa_, z_); kb0_ = KL0(1, Kt_, MB_); kqb_ = (QS_)[64];  CH(0); SBAR(); P1 = MF32(kb1_, kqa_, z_); kb1_ = KL1(1, Kt_, MB_); CH(1); SBAR(); \
        P0 = MF32(kb0_, kqb_, P0); kb0_ = KL0(2, Kt_, MB_); kqa_ = (QS_)[128]; CH(2); SBAR(); P1 = MF32(kb1_, kqb_, P1); kb1_ = KL1(2, Kt_, MB_); CH(3); SBAR(); \
        P0 = MF32(kb0_, kqa_, P0); kb0_ = KL0(3, Kt_, MB_); kqb_ = (QS_)[192]; CH(4); SBAR(); P1 = MF32(kb1_, kqa_, P1); kb1_ = KL1(3, Kt_, MB_); CH(5); SBAR(); \
        P0 = MF32(kb0_, kqb_, P0); CH(6); SBAR(); P1 = MF32(kb1_, kqb_, P1); CH(7); SBAR(); \
        if (REF_) { const bf16x8 on_ = __builtin_bit_cast(bf16x8, (u32x4){hi == 0 ? 0x3F803F80u : 0u, 0u, 0u, 0u}), ng_ = __builtin_bit_cast(bf16x8, (u32x4){(NEGM_), 0u, 0u, 0u}); \
          P0 = MF32(on_, ng_, P0); P1 = MF32(on_, ng_, P1); SBAR(); } } while (0)
#define VLD1(KS, D) do { vl_[D] = tr_read<v_rd_off(D, KS, 0)>(vb_); vh_[D] = tr_read<v_rd_off(D, KS, 1)>(vb_); } while (0)
#define PKV(D) (bf16x8){vl_[D][0], vl_[D][1], vl_[D][2], vl_[D][3], vh_[D][0], vh_[D][1], vh_[D][2], vh_[D][3]}
#define LGKM(N) asm volatile("s_waitcnt lgkmcnt(" #N ")" ::: "memory")
#define PV_ONE(o, f_, N, WN, CH) do { LGKM(WN); SBAR(); o[(N) & 3] = MF32(f_, PKV((N) & 3), o[(N) & 3]); if ((N) + 3 < 16) VLD1(((N) + 3) >> 2, ((N) + 3) & 3); CH(N); SBAR(); } while (0)
#define PV_SEG(o, pf, vbase, CH) do { const int vb_ = (vbase); s16x4 vl_[4], vh_[4]; \
        VLD1(0, 0); VLD1(0, 1); VLD1(0, 2); \
        PV_ONE(o, pf[0], 0, 4, CH);  PV_ONE(o, pf[0], 1, 4, CH);  PV_ONE(o, pf[0], 2, 4, CH);  PV_ONE(o, pf[0], 3, 4, CH); \
        PV_ONE(o, pf[1], 4, 4, CH);  PV_ONE(o, pf[1], 5, 4, CH);  PV_ONE(o, pf[1], 6, 4, CH);  PV_ONE(o, pf[1], 7, 4, CH); \
        PV_ONE(o, pf[2], 8, 4, CH);  PV_ONE(o, pf[2], 9, 4, CH);  PV_ONE(o, pf[2], 10, 4, CH); PV_ONE(o, pf[2], 11, 4, CH); \
        PV_ONE(o, pf[3], 12, 4, CH); PV_ONE(o, pf[3], 13, 4, CH); PV_ONE(o, pf[3], 14, 2, CH); PV_ONE(o, pf[3], 15, 0, CH); } while (0)
#define CH_NONE(k) do {} while (0)
#define CH_P2_0(k) sm2_chunk<k>(p0, p1, st0, pa, oa, ws)
#define CH_P1_1(k) sm1_chunk<k>(q0, q1)
#define CH_P2_1(k) sm2_chunk<k>(q0, q1, st1, pb, ob, ws)
#define CH_P1_0(k) sm1_chunk<k>(p0, p1)
#define RUN16(CH) do { CH(0); CH(1); CH(2); CH(3); CH(4); CH(5); CH(6); CH(7); CH(8); CH(9); CH(10); CH(11); CH(12); CH(13); CH(14); CH(15); } while (0)
#define RUN8(CH) do { CH(0); SBAR(); CH(1); SBAR(); CH(2); SBAR(); CH(3); SBAR(); CH(4); SBAR(); CH(5); SBAR(); CH(6); SBAR(); CH(7); SBAR(); } while (0)
    const int NT = nkeys / KVBLK;
    PDMA_K(0, 0); PDMA_V(0, 0); if (NT > 1) PDMA_K(1, 1);
    PWAIT_BAR();
    f32x16 p0, p1, q0, q1; bf16x8 pa[4], pb[4];
    QK_SEG(p0, p1, z0, qs, 0, 0u, CH_NONE, false);
    RUN16(CH_P1_0);
    int kb = 0;
    if (wid >= 4) __builtin_amdgcn_s_setprio(1);
    asm volatile(".p2align 8\n\t.fill 16, 4, 0xBF800000" ::: "memory");
    for (int j = 0; j + 1 < NT; ++j) {
        const int vbb = j & 1, kb1 = kb == 2 ? 0 : kb + 1, kb2 = kb1 == 2 ? 0 : kb1 + 1;
        if (j + 2 < NT) PDMA_K(j + 2, kb2);
        PDMA_V(j + 1, vbb ^ 1);
        const int vb = vb0 + vbb * (int)SHM_V;
        QK_SEG(q0, q1, z0 + kb * (int)SHM_K, qs + 256, 128, st1.negm, CH_P2_0, st1.upd);
        PV_SEG(oa, pa, vb, CH_P1_1);
        QK_SEG(p0, p1, z0 + kb1 * (int)SHM_K, qs, 0, st0.negm, CH_P2_1, st0.upd);
        PV_SEG(ob, pb, vb, CH_P1_0);
        PWAIT_BAR();
        kb = kb1;
    }
    { const int vb = vb0 + ((NT - 1) & 1) * (int)SHM_V;
      QK_SEG(q0, q1, z0 + kb * (int)SHM_K, qs + 256, 128, st1.negm, CH_P2_0, st1.upd);
      PV_SEG(oa, pa, vb, CH_P1_1);
      RUN8(CH_P2_1);
      PV_SEG(ob, pb, vb, CH_NONE); }
    __builtin_amdgcn_s_setprio(0);
    const float l0 = st0.l, l1 = st1.l;
    const int lane_e = opaque_lane(), r32e = lane_e & 31, hie = lane_e >> 5;
    if (hie == 0) { ws[r32e] = l0; ws[32 + r32e] = l1; }
    LDS_WAIT();
    float ss[16];
#pragma unroll
    for (int r = 0; r < 16; ++r) { const float ra = __builtin_amdgcn_rcpf(ws[crow(r, hie)]), rb = lam * __builtin_amdgcn_rcpf(ws[32 + crow(r, hie)]);
        float sq = 0.f;
#pragma unroll
        for (int d = 0; d < 4; ++d) { const float v = oa[d][r] * ra - ob[d][r] * rb; oa[d][r] = v; sq += v * v; }
        ss[r] = sq; }
#pragma unroll
    for (int r = 0; r < 16; ++r) {
        ss[r] = rsqrtf(half32_sum(ss[r]) * (1.f / 128.f) + NORM_EPS) * (1.f - LAM_INIT0);
    }
    float wv[4];
#pragma unroll
    for (int d = 0; d < 4; ++d) wv[d] = subw[d * 32 + r32e];
    bf16_t* Ow = Ob + (size_t)(wid * QBLK) * DM;
#pragma unroll
    for (int r = 0; r < 16; ++r) { const int orow = crow(r, hie);
#pragma unroll
        for (int d = 0; d < 4; ++d) Ow[(size_t)orow * DM + d * 32 + r32e] = (bf16_t)(cvt_pk_bf16(oa[d][r] * ss[r] * wv[d], 0.f) & 0xffffu); }
    __syncthreads();
#undef PDMA_K
#undef PDMA_V
#undef PWAIT_BAR
#undef KL0
#undef KL1
#undef QK_SEG
#undef VLD1
#undef PKV
#undef LGKM
#undef PV_ONE
#undef PV_SEG
#undef CH_NONE
#undef CH_P2_0
#undef CH_P1_1
#undef CH_P2_1
#undef CH_P1_0
#undef RUN16
#undef RUN8
}
#undef MF32
}

#ifndef ATT_PIPE
#define ATT_PIPE 1
#endif
#if ATT_PIPE
#define ATT_UNIT att::attn_unit_pipe
#else
#define ATT_UNIT att::attn_unit<0>
#endif
struct Args { const float* in[23]; float* out; unsigned char* ws; int ph_lo, ph_hi; };


__device__ __forceinline__ int map_qkv(int n0) {
    if (n0 >= 2048) return n0;
    const int sec = n0 >> 10, nn = n0 & 1023, blk = nn >> 6, half = (nn >> 5) & 1;
    return sec * 1024 + 256 * (blk >> 2) + 128 * half + 32 * (blk & 3);
}
__device__ __forceinline__ int map_gu(int n0) {
    const int half = n0 >> 10, nn = n0 & 1023;
    return 256 * (nn >> 7) + 128 * half + (nn & 127);
}

#ifndef PH_MASK
#define PH_MASK 0xFFFFFu
#endif
#define IN(k) (((PH_MASK >> (k)) & 1u) && lo <= (k) && (k) < hi_ph)
#ifndef MK_STAMP
#define MK_STAMP 0
#endif
#ifndef MK_STAMP_A
#define MK_STAMP_A 3
#endif
#ifndef MK_STAMP_B
#define MK_STAMP_B 0
#endif
#if MK_STAMP
#define STAMP(k) do { if (blockIdx.x == 0 && tid == 0) ((unsigned long long*)(ws + 40960))[(k)] = wall_clock64(); } while (0)
#else
#define STAMP(k) do {} while (0)
#endif
#define SEAM(k) do { if (IN(k) && IN((k) + 1)) xcd_barrier(bar, wave == 0 && opaque_lane() == 0); STAMP((k) + 1); } while (0)
#define MOD ((float*)(ws + WS_MOD))
#define ROPE ((float*)(ws + WS_ROPE))
#define HIST ((int*)(ws + WS_HIST))
#define BLKEXP ((int*)(ws + WS_BLKEXP))
#define WGT ((float*)(ws + WS_WGT))
#define TOKE ((int*)(ws + WS_TOKE))
#define TOKG ((float*)(ws + WS_TOKG))
#define TOKR ((int*)(ws + WS_TOKR))
#define ROWTOK ((unsigned*)(ws + WS_ROWTOK))
#define GZ ((float*)(ws + WS_GZ))
#define DEC ((float*)(ws + WS_DEC))
#define WQKV ((bf16_t*)(ws + WS_WQKV))
#define WO ((bf16_t*)(ws + WS_WO))
#define WGIN ((bf16_t*)(ws + WS_WGIN))
#define WGOUT ((bf16_t*)(ws + WS_WGOUT))
#define WGU ((unsigned char*)(ws + WS_WGU))
#define WD ((unsigned char*)(ws + WS_WD))
#define TB ((bf16_t*)(ws + WS_T))
#define QB ((bf16_t*)(ws + WS_Q))
#define KC ((bf16_t*)(ws + WS_KC))
#define VC ((bf16_t*)(ws + WS_VC))
#define AO ((bf16_t*)(ws + WS_AO))
#define YB ((bf16_t*)(ws + WS_Y))
#define UB ((unsigned char*)(ws + WS_U))
#define X1 ((bf16_t*)(ws + WS_X1))
#define X2 ((bf16_t*)(ws + WS_X2))
#define XS ((unsigned char*)(ws + WS_XS))
#define XSB16 ((bf16_t*)(ws + WS_XS))
#define HB ((unsigned char*)(ws + WS_H))
#define YD XS
#define GQ QB
#define GK (QB + (size_t)T0 * 512)
#define GV KC
#define GR VC
#define DS ((bf16_t*)(ws + WS_H))


template <int L>
__device__ __forceinline__ void moe_layer(unsigned char* ws, unsigned char* lds, const XcdBarrier& bar, const int lo, const int hi_ph, const int wave, const int pvar) {
    const int lane = (int)__lane_id(), tid = wave * 64 + lane;
    const int G = gridDim.x, blk = blockIdx.x;
    constexpr int NT = L == 0 ? T0 : TLAT;
    constexpr int pb = L == 0 ? 5 : 15;
    const float* modl = MOD + (size_t)L * 5 * 6144;
    const int per = NT / G;
    if (IN(pb)) {
        const int lane = opaque_lane(), tid = wave * 64 + lane; (void)tid; (void)lane;
        bf16_t* UH = (bf16_t*)lds;
        bf16_t* UL = (bf16_t*)(lds + 33024);
        float* PART = (float*)(lds + 66560);
        int* HL = (int*)(lds + 98304);
        const float* lng = INP(I_LNG) + (size_t)(L * 2 + 0) * DM; const float* lnb = INP(I_LNB) + (size_t)(L * 2 + 0) * DM;
        const float* rw = INP(I_RW) + (size_t)L * DM * NEXP; const float* rb = INP(I_RB) + L * NEXP;
        const int e = lane & 31, hh = lane >> 5;
        bf16x8 wh[4][2], wl[4][2];
#pragma unroll
        for (int ks = 0; ks < 4; ++ks)
#pragma unroll
            for (int cb = 0; cb < 2; ++cb) { unsigned hw[4], lw[4];
#pragma unroll
                for (int jp = 0; jp < 4; ++jp) { const int k = 128 * wave + 32 * ks + 8 * (lane >> 4) + 2 * jp;
                    const float w0 = rw[(size_t)k * NEXP + 16 * cb + (lane & 15)], w1 = rw[(size_t)(k + 1) * NEXP + 16 * cb + (lane & 15)];
                    const unsigned hp = cvt_pk_bf16(w0, w1); hw[jp] = hp; lw[jp] = cvt_pk_bf16(w0 - bflo(hp), w1 - bfhi(hp)); }
                wh[ks][cb] = __builtin_bit_cast(bf16x8, (u32x4){hw[0], hw[1], hw[2], hw[3]}); wl[ks][cb] = __builtin_bit_cast(bf16x8, (u32x4){lw[0], lw[1], lw[2], lw[3]}); }
        if (tid < 32) HL[tid] = 0;
        __syncthreads();
        const int t0 = blk * per;
        f32x4 xn[4]; u32x2 yn[4];
#define ROW_PTRS(bt_, q_, xin_, yin_, ok_) const int rr_ = 2 * wave + (q_), r_ = t0 + (bt_) + rr_; const bool ok_ = (bt_) + rr_ < per && (bt_) < per; \
        const void* xin_ = L == 0 ? (const void*)(r_ < TLAT ? INP(I_X) + (size_t)r_ * DM : INP(I_CTX) + (size_t)(r_ - TLAT) * DM) : (const void*)(X2 + (size_t)r_ * DM); const bf16_t* yin_ = YB + (size_t)r_ * DM
        { ROW_PTRS(0, 0, xp, yp, okp);
          if (okp) {
#pragma unroll
              for (int j = 0; j < 4; ++j) { xn[j] = L == 0 ? *(const f32x4*)((const float*)xp + 4 * lane + 256 * j) : bf4_f32(*(const u32x2*)((const bf16_t*)xp + 4 * lane + 256 * j)); yn[j] = *(const u32x2*)(yp + 4 * lane + 256 * j); } } }
        for (int bt = 0; bt < per; bt += 16) {
#pragma unroll 1
            for (int q = 0; q < 2; ++q) { const int rr = 2 * wave + q, r = t0 + bt + rr;
                f32x4 xc[4]; u32x2 yc[4];
#pragma unroll
                for (int j = 0; j < 4; ++j) { xc[j] = xn[j]; yc[j] = yn[j]; }
                { const int nbt = q == 0 ? bt : bt + 16, nq = q ^ 1;
                  ROW_PTRS(nbt, nq, xp, yp, okp);
                  if (okp) {
#pragma unroll
                      for (int j = 0; j < 4; ++j) { xn[j] = L == 0 ? *(const f32x4*)((const float*)xp + 4 * lane + 256 * j) : bf4_f32(*(const u32x2*)((const bf16_t*)xp + 4 * lane + 256 * j)); yn[j] = *(const u32x2*)(yp + 4 * lane + 256 * j); } } }
                if (bt + rr < per && !(pvar & 2)) {
                    const int mrow = r < TLAT ? (r >> 13) : 4;
                    const float* mod = modl + (size_t)mrow * 6144;
                    f32x4 v[4]; float s = 0.f;
#pragma unroll
                    for (int j = 0; j < 4; ++j) { const int idx = 4 * lane + 256 * j; const f32x4 xv = xc[j], g1 = *(const f32x4*)(mod + 2048 + idx);
                        const u32x2 yy = yc[j];
                        v[j][0] = ALPHA * xv[0] + g1[0] * bflo(yy.x); v[j][1] = ALPHA * xv[1] + g1[1] * bfhi(yy.x); v[j][2] = ALPHA * xv[2] + g1[2] * bflo(yy.y); v[j][3] = ALPHA * xv[3] + g1[3] * bfhi(yy.y);
                        s += (v[j][0] + v[j][1]) + (v[j][2] + v[j][3]); }
                    const float mean = wave_sum(s) * (1.f / DM); float s2 = 0.f;
#pragma unroll
                    for (int j = 0; j < 4; ++j) { v[j] = v[j] - mean; s2 += (v[j][0] * v[j][0] + v[j][1] * v[j][1]) + (v[j][2] * v[j][2] + v[j][3] * v[j][3]); }
                    const float rstd = rsqrtf(wave_sum(s2) * (1.f / DM) + NORM_EPS);
#pragma unroll
                    for (int j = 0; j < 4; ++j) { const int idx = 4 * lane + 256 * j; const f32x4 gg = *(const f32x4*)(lng + idx), bb = *(const f32x4*)(lnb + idx);
                        const f32x4 sh = *(const f32x4*)(mod + 3072 + idx), sc = *(const f32x4*)(mod + 4096 + idx);
                        f32x4 x1 = v[j] * rstd * gg + bb;
                        { u32x2 o1; o1.x = cvt_pk_bf16(x1[0], x1[1]); o1.y = cvt_pk_bf16(x1[2], x1[3]); *(u32x2*)(X1 + (size_t)r * DM + idx) = o1; }
                        f32x4 u = x1 * (1.f + sc) + sh;
                        { u32x2 uh, ul; uh.x = cvt_pk_bf16(u[0], u[1]); uh.y = cvt_pk_bf16(u[2], u[3]);
                          ul.x = cvt_pk_bf16(u[0] - bflo(uh.x), u[1] - bfhi(uh.x)); ul.y = cvt_pk_bf16(u[2] - bflo(uh.y), u[3] - bfhi(uh.y));
                          *(u32x2*)(UH + rr * 1032 + idx) = uh; *(u32x2*)(UL + rr * 1032 + idx) = ul; }
                        *(unsigned*)(UB + (size_t)r * DM + idx) = pg8::pk4_fp8(u[0], u[1], u[2], u[3]); }
                }
            }
#undef ROW_PTRS
            __syncthreads();
            if (!(pvar & 1)) {
            { f32x4 lacc[2] = {{0.f, 0.f, 0.f, 0.f}, {0.f, 0.f, 0.f, 0.f}};
#pragma unroll
              for (int ks = 0; ks < 4; ++ks) { const int ko = (lane & 15) * 1032 + 128 * wave + 32 * ks + 8 * (lane >> 4);
                  const bf16x8 ah = *(const bf16x8*)(UH + ko), al = *(const bf16x8*)(UL + ko);
#pragma unroll
                  for (int cb = 0; cb < 2; ++cb) {
                      lacc[cb] = __builtin_amdgcn_mfma_f32_16x16x32_bf16(ah, wh[ks][cb], lacc[cb], 0, 0, 0);
                      lacc[cb] = __builtin_amdgcn_mfma_f32_16x16x32_bf16(al, wh[ks][cb], lacc[cb], 0, 0, 0);
                      lacc[cb] = __builtin_amdgcn_mfma_f32_16x16x32_bf16(ah, wl[ks][cb], lacc[cb], 0, 0, 0); } }
#pragma unroll
              for (int cb = 0; cb < 2; ++cb)
#pragma unroll
                  for (int i = 0; i < 4; ++i) PART[(wave * 16 + 4 * (lane >> 4) + i) * 32 + 16 * cb + (lane & 15)] = lacc[cb][i]; }
            __syncthreads();
            { const int rr = 2 * wave + hh, r = t0 + bt + rr;
              float lg = rb[e];
#pragma unroll
              for (int w = 0; w < 8; ++w) lg += PART[(w * 16 + rr) * 32 + e];
              float tv[4]; int ti[4];
#pragma unroll
              for (int t = 0; t < 4; ++t) { const float mx = half_max(lg, hh);
                  int cand = half_min((lg == mx) ? e : 99, hh);
                  cand = cand > 31 ? t : cand;
                  tv[t] = mx; ti[t] = cand; if (e == cand) lg = -__builtin_inff(); }
              if (bt + rr < per && e == 0) {
                  const float e1 = __expf(tv[1] - tv[0]), e2 = __expf(tv[2] - tv[0]), e3 = __expf(tv[3] - tv[0]); const float inv = 1.f / (1.f + e1 + e2 + e3);
                  *(f32x4*)(TOKG + (size_t)r * 4) = (f32x4){inv, e1 * inv, e2 * inv, e3 * inv};
                  int* te = TOKE + (size_t)r * 4; te[0] = ti[0]; te[1] = ti[1]; te[2] = ti[2]; te[3] = ti[3];
                  atomicAdd(&HL[ti[0]], 1); atomicAdd(&HL[ti[1]], 1); atomicAdd(&HL[ti[2]], 1); atomicAdd(&HL[ti[3]], 1); } }
            }
            __syncthreads();
        }
        if (tid < 32) HIST[blk * 32 + tid] = HL[tid];
    }
    SEAM(pb);

    if (IN(pb + 1)) {
        const int lane = opaque_lane(), tid = wave * 64 + lane; (void)tid; (void)lane;
        int* SA = (int*)lds; int* SB_ = SA + 512; int* PS = SB_ + 512; int* BASE = PS + 64; int* EL = BASE + 32; int* RL = EL + 1024;
        { const int e = tid & 31, part = tid >> 5; int sa = 0, sb = 0;
#pragma unroll 8
          for (int bb = part; bb < G; bb += 16) { const int hv = HIST[bb * 32 + e]; sa += hv; if (bb < blk) sb += hv; }
          SA[part * 32 + e] = sa; SB_[part * 32 + e] = sb; }
        __syncthreads();
        if (tid < 32) { int tot = 0, bef = 0;
            for (int p = 0; p < 16; ++p) { tot += SA[p * 32 + tid]; bef += SB_[p * 32 + tid]; }
            const int padded = (tot + 255) & ~255;
            int incl = padded;
#pragma unroll
            for (int o = 1; o < 32; o <<= 1) { const int t = __shfl_up(incl, o); if (tid >= o) incl += t; }
            const int pstart = incl - padded;
            PS[tid] = pstart; BASE[tid] = pstart + bef; PS[32 + tid] = pstart + tot;
            if (blk == 0) {
                for (int rbk = pstart >> 8; rbk < (incl >> 8); ++rbk) BLKEXP[rbk] = tid; BLKEXP[600 + tid] = pstart >> 8; BLKEXP[640 + tid] = padded >> 8; if (tid == 31) BLKEXP[1023] = incl >> 8; } }
        const int t0 = blk * per, na = per * 4;
        for (int i = tid; i < na; i += 512) EL[i] = TOKE[(size_t)t0 * 4 + i];
        __syncthreads();
        if (blk == 0) { const int e = tid >> 4, j = tid & 15; const int end = (PS[32 + e] + 255) & ~255;
            for (int rr = PS[32 + e] + j; rr < end; rr += 16) ROWTOK[rr] = 0u; }
        { int* CNT = RL + 1024;
          const int nch = (na + 63) >> 6;
          int myr[2] = {0, 0}, mye[2] = {-1, -1};
#pragma unroll
          for (int k = 0; k < 2; ++k) { const int c = wave + 8 * k;
              if (c < nch) { const int i = c * 64 + lane; const int ei = i < na ? EL[i] : -1; int r_ = 0, cn_ = 0;
                  for (int e = 0; e < 32; ++e) { const unsigned long long m = __ballot(ei == e);
                      const int below = (int)__builtin_amdgcn_mbcnt_hi((unsigned)(m >> 32), __builtin_amdgcn_mbcnt_lo((unsigned)m, 0u));
                      if (ei == e) r_ = below; if (lane == e) cn_ = __popcll(m); }
                  if (lane < 32) CNT[c * 32 + lane] = cn_;
                  myr[k] = r_; mye[k] = ei; } }
          __syncthreads();
#pragma unroll
          for (int k = 0; k < 2; ++k) { const int c = wave + 8 * k;
              if (c < nch && mye[k] >= 0) { int base = BASE[mye[k]]; for (int cc = 0; cc < c; ++cc) base += CNT[cc * 32 + mye[k]];
                  RL[c * 64 + lane] = base + myr[k]; } } }
        __syncthreads();
        for (int i = tid; i < na; i += 512) TOKR[(size_t)t0 * 4 + i] = RL[i];
        for (int i = tid; i < na; i += 512) ROWTOK[RL[i]] = (unsigned)(t0 + (i >> 2)) * (unsigned)DM;
    }
    SEAM(pb + 1);

    if (IN(pb + 2)) {
        const int lane = opaque_lane(), tid = wave * 64 + lane; (void)tid; (void)lane;
        const int nblk = __builtin_amdgcn_readfirstlane(BLKEXP[1023]);
        pg8::MoeOrder S; S.init(UB, WGU + (size_t)L * 32 * 2048 * 1024, BLKEXP, nblk, 8, G, blk, 1);
        pg8::EpiGateUp E{ws, lds, L};
        pg8::gemm_phase<pg8::EpiGateUp, pg8::MoeOrder, true, true, 1, true>((LAS unsigned char*)lds, S, E, wave, ROWTOK);
    }
    SEAM(pb + 2);

    if (IN(pb + 3)) {
        const int lane = opaque_lane(), tid = wave * 64 + lane; (void)tid; (void)lane;
        const int nblk = __builtin_amdgcn_readfirstlane(BLKEXP[1023]);
        pg8::MoeOrder S; S.init(HB, WD + (size_t)L * 32 * 1024 * 1024, BLKEXP, nblk, 4, G, blk, 1);
        pg8::EpiDown E{ws, lds, L};
        pg8::gemm_phase<pg8::EpiDown, pg8::MoeOrder, true, true, 1>((LAS unsigned char*)lds, S, E, wave);
    }
    SEAM(pb + 3);

    if (IN(pb + 4)) {
        const int lane = opaque_lane(), tid = wave * 64 + lane; (void)tid; (void)lane;
        const float* lng = INP(I_LNG) + (size_t)(L * 2 + 1) * DM; const float* lnb = INP(I_LNB) + (size_t)(L * 2 + 1) * DM;
        const int rstep = G * 8;
        f32x4 gt_n, gt_nn; int rw_n[4], rw_nn[4]; unsigned yn[4][4]; u32x2 xn[4];
#define LD_IDX(r_, g_, w_) do { if ((r_) < NT) { g_ = *(const f32x4*)(TOKG + (size_t)(r_) * 4); const int* tr_ = TOKR + (size_t)(r_) * 4; w_[0] = tr_[0]; w_[1] = tr_[1]; w_[2] = tr_[2]; w_[3] = tr_[3]; } } while (0)
#define LD_DATA(r_, w_) do { if ((r_) < NT) { _Pragma("unroll") for (int j = 0; j < 4; ++j) { const int idx = 4 * lane + 256 * j; \
            _Pragma("unroll") for (int k = 0; k < 4; ++k) yn[k][j] = *(const unsigned*)(YD + (size_t)w_[k] * DM + idx); \
            xn[j] = *(const u32x2*)(X1 + (size_t)(r_) * DM + idx); } } } while (0)
        { const int r0 = blk * 8 + wave; LD_IDX(r0, gt_n, rw_n); LD_DATA(r0, rw_n); LD_IDX(r0 + rstep, gt_nn, rw_nn); }
        for (int r = blk * 8 + wave; r < NT; r += rstep) {
            const int mrow = r < TLAT ? (r >> 13) : 4;
            const float* mod = modl + (size_t)mrow * 6144;
            const f32x4 gt = gt_n;
            unsigned yc[4][4]; u32x2 xc[4];
#pragma unroll
            for (int j = 0; j < 4; ++j) { xc[j] = xn[j];
#pragma unroll
                for (int k = 0; k < 4; ++k) yc[k][j] = yn[k][j]; }
            gt_n = gt_nn;
#pragma unroll
            for (int k = 0; k < 4; ++k) rw_n[k] = rw_nn[k];
            LD_DATA(r + rstep, rw_n);
            LD_IDX(r + 2 * rstep, gt_nn, rw_nn);
            f32x4 v[4]; float s = 0.f;
#pragma unroll
            for (int j = 0; j < 4; ++j) { const int idx = 4 * lane + 256 * j;
                const f32x4 xv = bf4_f32(xc[j]), g2 = *(const f32x4*)(mod + 5120 + idx);
                f32x4 f = {0.f, 0.f, 0.f, 0.f};
#pragma unroll
                for (int k = 0; k < 4; ++k) { const f32x2 lo = __builtin_amdgcn_cvt_pk_f32_fp8((int)yc[k][j], false), hi = __builtin_amdgcn_cvt_pk_f32_fp8((int)yc[k][j], true);
                    const float gk = gt[k] * (1.f / pg8::Y_SCALE);
                    f[0] += gk * lo[0]; f[1] += gk * lo[1]; f[2] += gk * hi[0]; f[3] += gk * hi[1]; }
                v[j] = ALPHA * xv + g2 * f;
                s += (v[j][0] + v[j][1]) + (v[j][2] + v[j][3]); }
            const float mean = wave_sum(s) * (1.f / DM); float s2 = 0.f;
#pragma unroll
            for (int j = 0; j < 4; ++j) { v[j] = v[j] - mean; s2 += (v[j][0] * v[j][0] + v[j][1] * v[j][1]) + (v[j][2] * v[j][2] + v[j][3] * v[j][3]); }
            const float rstd = rsqrtf(wave_sum(s2) * (1.f / DM) + NORM_EPS);
#pragma unroll
            for (int j = 0; j < 4; ++j) { const int idx = 4 * lane + 256 * j; const f32x4 gg = *(const f32x4*)(lng + idx), bb = *(const f32x4*)(lnb + idx);
                const f32x4 x2 = v[j] * rstd * gg + bb;
                if (L == 0) {
                    { u32x2 o2; o2.x = cvt_pk_bf16(x2[0], x2[1]); o2.y = cvt_pk_bf16(x2[2], x2[3]); *(u32x2*)(X2 + (size_t)r * DM + idx) = o2; }
                    const float* mod1 = MOD + (size_t)(5 + mrow) * 6144;
                    const f32x4 sh = *(const f32x4*)(mod1 + idx), sc = *(const f32x4*)(mod1 + 1024 + idx);
                    const f32x4 t = x2 * (1.f + sc) + sh;
                    u32x2 o; o.x = cvt_pk_bf16(t[0], t[1]); o.y = cvt_pk_bf16(t[2], t[3]);
                    *(u32x2*)(TB + (size_t)r * DM + idx) = o;
                } else *(f32x4*)((float*)INP(23) + (size_t)r * DM + idx) = x2; }
        }
#undef LD_IDX
#undef LD_DATA
    }
    if (L == 0) SEAM(pb + 4);
}

template <int MAP>
__device__ __forceinline__ void transpose_item_fp8(const float* __restrict__ W, int N, unsigned char* __restrict__ WT, int k0, int n0, float scale, char* scr, int lane) {
    const int kr = lane >> 3, nc = (lane & 7) * 4;
    f32x4 v[16];
    const float* src = W + (size_t)(k0 + 16 * kr) * N + n0 + nc;
#pragma unroll
    for (int i = 0; i < 16; ++i) v[i] = *(const f32x4*)(src + (size_t)i * N) * scale;
#pragma unroll
    for (int jn = 0; jn < 4; ++jn) {
        u32x4 c0;
        c0.x = pg8::pk4_fp8(v[0][jn], v[1][jn], v[2][jn], v[3][jn]); c0.y = pg8::pk4_fp8(v[4][jn], v[5][jn], v[6][jn], v[7][jn]);
        c0.z = pg8::pk4_fp8(v[8][jn], v[9][jn], v[10][jn], v[11][jn]); c0.w = pg8::pk4_fp8(v[12][jn], v[13][jn], v[14][jn], v[15][jn]);
        *(u32x4*)(scr + (nc + jn) * 144 + kr * 16) = c0;
    }
    LDS_WAIT(); asm volatile("" ::: "memory");
    const int c = lane & 7;
    const int drow0 = MAP == 2 ? map_gu(n0) : MAP == 1 ? map_qkv(n0) : n0;
#pragma unroll
    for (int j = 0; j < 4; ++j) { const int n = (lane >> 3) + 8 * j;
        const u32x4 o = *(const u32x4*)(scr + n * 144 + 16 * c);
        *(u32x4*)(WT + (size_t)(drow0 + n) * 1024 + k0 + 16 * c) = o; }
    LDS_WAIT(); asm volatile("" ::: "memory");
}

template <int MAP>
__device__ __forceinline__ void transpose_item64(const float* __restrict__ W, int N, bf16_t* __restrict__ WT, int k0, int n0, char* scr, int lane) {
    const int kr = lane >> 4, nc = (lane & 15) * 4;
    const bool ok = n0 + nc < N;
    f32x4 v[16];
    const float* src = W + (size_t)(k0 + 16 * kr) * N + n0 + nc;
#pragma unroll
    for (int i = 0; i < 16; ++i) v[i] = ok ? *(const f32x4*)(src + (size_t)i * N) : (f32x4){0.f, 0.f, 0.f, 0.f};
#pragma unroll
    for (int jn = 0; jn < 4; ++jn) {
        u32x4 c0, c1;
        c0.x = cvt_pk_bf16(v[0][jn], v[1][jn]); c0.y = cvt_pk_bf16(v[2][jn], v[3][jn]); c0.z = cvt_pk_bf16(v[4][jn], v[5][jn]); c0.w = cvt_pk_bf16(v[6][jn], v[7][jn]);
        c1.x = cvt_pk_bf16(v[8][jn], v[9][jn]); c1.y = cvt_pk_bf16(v[10][jn], v[11][jn]); c1.z = cvt_pk_bf16(v[12][jn], v[13][jn]); c1.w = cvt_pk_bf16(v[14][jn], v[15][jn]);
        *(u32x4*)(scr + (nc + jn) * 144 + kr * 32) = c0; *(u32x4*)(scr + (nc + jn) * 144 + kr * 32 + 16) = c1;
    }
    LDS_WAIT(); asm volatile("" ::: "memory");
    const int c = lane & 7;
#pragma unroll
    for (int j = 0; j < 8; ++j) { const int n = (lane >> 3) + 8 * j;
        const u32x4 o = *(const u32x4*)(scr + n * 144 + 16 * c);
        const int ng = n0 + (n & 32);
        const int drow = (MAP == 1 ? map_qkv(ng) : MAP == 2 ? map_gu(ng) : ng) + (n & 31);
        if (n0 + n < N) *(u32x4*)(WT + (size_t)drow * 1024 + k0 + 8 * c) = o; }
    LDS_WAIT(); asm volatile("" ::: "memory");
}

__global__ void __launch_bounds__(512, 2) fwd_kernel(Args args) {
    extern __shared__ __attribute__((aligned(16))) unsigned char lds[];
    const int wave = __builtin_amdgcn_readfirstlane((int)threadIdx.x >> 6), lane = opaque_lane(), tid = wave * 64 + lane;
    const int G = gridDim.x, blk = blockIdx.x;
    unsigned char* ws = args.ws;
    const int lo = args.ph_lo & 0xFF, hi_ph = args.ph_hi, pvar = args.ph_lo >> 8;

    volatile LAS unsigned* misc = (volatile LAS unsigned*)((LAS unsigned char*)lds + LDS_MISC);
    if (tid < 4) misc[tid] = 0u;
    if (tid < 24) { const unsigned long long p = tid < 23 ? (unsigned long long)args.in[tid] : (unsigned long long)args.out; *(unsigned long long*)(lds + LDS_MISC + 64 + 8 * tid) = p; }
    __syncthreads();
    XcdBarrier bar; bar.bar = (unsigned*)(ws + WS_CTL); bar.x = 0; bar.st = misc;
    if (hi_ph - lo > 1) bar = xcd_barrier_post((unsigned*)(ws + WS_CTL), misc, wave == 0 && opaque_lane() == 0);
    STAMP(0);


    if (IN(0)) {
        const int lane = opaque_lane(), tid = wave * 64 + lane; (void)tid; (void)lane;
        float* S = (float*)lds;
        float* PART = (float*)lds + 5 * 1024;
        for (int i = tid; i < 5 * 1024; i += 512) { const int r = i >> 10, k = i & 1023; const float v = r < 4 ? INP(I_C)[r * 1024 + k] : INP(I_CCTX)[k]; S[i] = siluf(v); }
        __syncthreads();
        for (int item = blk; item < 256; item += G) {
            const int l = item >> 7, n = (item & 127) * 48 + (lane < 48 ? lane : 47);
            const float* wp = INP(I_ADAW) + (size_t)l * 1024 * 6144 + n;
            float a0 = 0.f, a1 = 0.f, a2 = 0.f, a3 = 0.f, a4 = 0.f;
#pragma unroll 8
            for (int kk = 0; kk < 128; ++kk) { const int k = wave * 128 + kk; const float w = wp[(size_t)k * 6144];
                a0 += S[k] * w; a1 += S[1024 + k] * w; a2 += S[2048 + k] * w; a3 += S[3072 + k] * w; a4 += S[4096 + k] * w; }
            float* pp = PART + wave * 320 + lane;
            pp[0] = a0; pp[64] = a1; pp[128] = a2; pp[192] = a3; pp[256] = a4;
            __syncthreads();
            if (tid < 320) { const int r = tid >> 6, ln = tid & 63; float s = 0.f;
#pragma unroll
                for (int w = 0; w < 8; ++w) s += PART[w * 320 + r * 64 + ln];
                const int nn = (item & 127) * 48 + ln;
                if (ln < 48) MOD[((size_t)l * 5 + r) * 6144 + nn] = s + INP(I_ADAB)[l * 6144 + nn]; }
            __syncthreads();
        }
        if (blk == G - 1) for (int i = tid; i < 2048; i += 512) { const int v = i >> 4, jj = i & 15; const float inv = powf(10000.f, -(float)jj / 16.f); const float ang = (float)v * inv;
            ROPE[2 * i] = cosf(ang); ROPE[2 * i + 1] = sinf(ang); }
        for (int i = blk * 512 + tid; i < 2 * 512 * 16; i += G * 512) { const int r = i & 15, col = (i >> 4) & 511, dir = i >> 13; WGT[i] = INP(I_GWGATE)[(size_t)(dir * 16 + r) * 512 + col]; }
        for (int i = blk * 512 + tid; i < (GIN_NP - GIN_N) * 1024 / 8; i += G * 512) ((u32x4*)(WGIN + (size_t)GIN_N * 1024))[i] = (u32x4){0u, 0u, 0u, 0u};
        __syncthreads();
        char* scr = (char*)lds + wave * 9216;
        const int gw = blk * 8 + wave, NGW = G * 8;
        constexpr int I_A = 16 * 48, I_B = 16 * 16, I_C2 = 16 * 49, I_D = 16 * 16, I_SMALL = I_A + I_B + I_C2 + I_D, I_GUx = 64 * 16 * 32, I_DNx = 64 * 16 * 16;
        for (int it = gw; it < I_SMALL + I_GUx + I_DNx; it += NGW) {
            int r = it;
            if (r < I_A) { const int kb = r / 96, nb = r % 96; transpose_item_fp8<1>(INP(I_DAWIN), 3072, (unsigned char*)WQKV, 128 * kb, 32 * nb, pg8::QKV_SCALE, scr, lane); continue; } r -= I_A;
            if (r < I_B) { const int kb = r >> 4, nb = r & 15; transpose_item64<0>(INP(I_DAWOUT), 1024, WO, 64 * kb, 64 * nb, scr, lane); continue; } r -= I_B;
            if (r < I_C2) { const int kb = r / 49, nb = r % 49; transpose_item64<0>(INP(I_GWIN), GIN_N, WGIN, 64 * kb, 64 * nb, scr, lane); continue; } r -= I_C2;
            if (r < I_D) { const int kb = r >> 4, nb = r & 15; transpose_item64<0>(INP(I_GWOUT), 1024, WGOUT, 64 * kb, 64 * nb, scr, lane); continue; } r -= I_D;
            if (r < I_GUx) { const int mat = r >> 9, q = r & 511, kb = q >> 6, nb = q & 63;
                transpose_item_fp8<2>(INP(I_WGU) + (size_t)mat * 1024 * 2048, 2048, WGU + (size_t)mat * 2048 * 1024, 128 * kb, 32 * nb, pg8::WGU_SCALE, scr, lane); continue; } r -= I_GUx;
            { const int mat = r >> 8, q = r & 255, kb = q >> 5, nb = q & 31;
                transpose_item_fp8<0>(INP(I_WD) + (size_t)mat * 1024 * 1024, 1024, WD + (size_t)mat * 1024 * 1024, 128 * kb, 32 * nb, pg8::WD_SCALE, scr, lane); }
        }
    }
    SEAM(0);

    if (IN(1)) {
        const int lane = opaque_lane(), tid = wave * 64 + lane; (void)tid; (void)lane;
        for (int r = blk * 8 + wave; r < T0; r += G * 8) {
            const float* src = r < TLAT ? INP(I_X) + (size_t)r * DM : INP(I_CTX) + (size_t)(r - TLAT) * DM;
            const float* mod = MOD + (size_t)(r < TLAT ? (r >> 13) : 4) * 6144;
#pragma unroll
            for (int j = 0; j < 4; ++j) { const int idx = 4 * lane + 256 * j;
                const f32x4 v = *(const f32x4*)(src + idx), sh = *(const f32x4*)(mod + idx), sc = *(const f32x4*)(mod + 1024 + idx);
                *(unsigned*)((unsigned char*)TB + (size_t)r * DM + idx) = pg8::pk4_fp8(v[0] * (1.f + sc[0]) + sh[0], v[1] * (1.f + sc[1]) + sh[1], v[2] * (1.f + sc[2]) + sh[2], v[3] * (1.f + sc[3]) + sh[3]); }
        }
    }
    SEAM(1);

    if (IN(2)) {
        const int lane = opaque_lane(), tid = wave * 64 + lane; (void)tid; (void)lane;
        pg8::DenseOrder S; S.init(TB, WQKV, T0, 3072, G, blk, 1);
        pg8::EpiQKV E{QB, KC, VC, ROPE};
        pg8::gemm_phase<pg8::EpiQKV, pg8::DenseOrder, true, true, 1>((LAS unsigned char*)lds, S, E, wave);
    }
    SEAM(2);

    if (IN(3)) {
        const int lane = opaque_lane(), tid = wave * 64 + lane; (void)tid; (void)lane;
        const float* lv = INP(I_DALAM);
        const float s1 = wave_sum(lv[lane] * lv[64 + lane]), s2 = wave_sum(lv[128 + lane] * lv[192 + lane]);
        const float lam = __builtin_bit_cast(float, __builtin_amdgcn_readfirstlane(__builtin_bit_cast(int, expf(s1) - expf(s2) + LAM_INIT0)));
        for (int i = 0;; ++i) {
            const int L = i * G + blk;
            if (L >= 1024 + 32) break;
            if (L < 1024) {
                int bh, qb;
                if (G == 256) { bh = i * 8 + (blk & 7); qb = blk >> 3; }
                else { bh = L >> 5; qb = L & 31; }
                const int b = bh >> 3, h = bh & 7;
                ATT_UNIT(QB + ((size_t)b * SEQ + qb * 256) * DM + h * 128, KC + (size_t)b * KVLEN * DM + h * 128, VC + (size_t)b * KVLEN * DM + h * 128,
                               AO + ((size_t)b * SEQ + qb * 256) * DM + h * 128, KVLEN, lam, INP(I_DASUBLN), (char*)lds, wave);
            } else {
                const int bh = L - 1024, b = bh >> 3, h = bh & 7;
                ATT_UNIT(QB + ((size_t)TLAT + b * NCTX) * DM + h * 128, KC + (size_t)b * KVLEN * DM + h * 128, VC + (size_t)b * KVLEN * DM + h * 128,
                               AO + ((size_t)TLAT + b * NCTX) * DM + h * 128, NCTX, lam, INP(I_DASUBLN), (char*)lds, wave);
            }
        }
    }
    SEAM(3);

    if (IN(4)) {
        const int lane = opaque_lane(), tid = wave * 64 + lane; (void)tid; (void)lane;
        pg8::DenseOrder S; S.init(AO, WO, T0, 1024, G, blk);
        pg8::EpiPlain E{YB};
        pg8::gemm_phase<pg8::EpiPlain, pg8::DenseOrder, true, true>((LAS unsigned char*)lds, S, E, wave);
    }
    SEAM(4);

    moe_layer<0>(ws, lds, bar, lo, hi_ph, wave, pvar);

    {
    if (IN(10)) {
        const int lane = opaque_lane(), tid = wave * 64 + lane; (void)tid; (void)lane;
        pg8::DenseOrder S; S.init(TB, WGIN, T0, GIN_NP, G, blk);
        pg8::EpiGlaIn E{GQ, GK, GV, GR, GZ};
        pg8::gemm_phase<pg8::EpiGlaIn, pg8::DenseOrder, true, true>((LAS unsigned char*)lds, S, E, wave);
    }
    SEAM(10);

    char* VL = (char*)lds;
    float* ZL = (float*)(lds + 32768);
    float* TOT = (float*)(lds + 40960);
    bf16_t* QL = (bf16_t*)(lds + 45056);
    bf16_t* KL = (bf16_t*)(lds + 63488);
    bf16_t* QI1 = (bf16_t*)(lds + 81920);
    bf16_t* KI1 = (bf16_t*)(lds + 100352);
    bf16_t* ATT = (bf16_t*)(lds + 118784);
    float* OL = (float*)lds;
    const float* bgt = INP(I_GBGATE);
#define GLA_STAGE(rowb_, withq_) do { const int sr_ = tid >> 4, sc_ = (tid & 15) * 8; \
        _Pragma("unroll") for (int th_ = 0; th_ < 2; ++th_) _Pragma("unroll") for (int hf_ = 0; hf_ < 2; ++hf_) \
            *(bf16x8*)(VL + th_ * 16384 + att::v_st(sr_ + 32 * hf_, sc_)) = *(const bf16x8*)(GV + ((rowb_) + sr_ + 32 * hf_) * 1024 + h * 256 + th_ * 128 + sc_); \
        _Pragma("unroll") for (int hf_ = 0; hf_ < 2; ++hf_) { *(bf16x8*)(KL + (sr_ + 32 * hf_) * 136 + sc_) = *(const bf16x8*)(GK + ((rowb_) + sr_ + 32 * hf_) * 512 + h * 128 + sc_); \
            if (withq_) *(bf16x8*)(QL + (sr_ + 32 * hf_) * 136 + sc_) = *(const bf16x8*)(GQ + ((rowb_) + sr_ + 32 * hf_) * 512 + h * 128 + sc_); } \
        *(f32x4*)(ZL + 4 * tid) = *(const f32x4*)(GZ + (rowb_) * 32 + 4 * tid); } while (0)
#define GLA_GATES_LOCAL(dir_, g) do { const int d_ = tid & 127, cg_ = tid >> 7; \
        { float wv_[16]; const f32x4* wp_ = (const f32x4*)(WGT + (size_t)((dir_) * 512 + h * 128 + d_) * 16); \
          _Pragma("unroll") for (int r_ = 0; r_ < 4; ++r_) { const f32x4 t_ = wp_[r_]; wv_[4 * r_] = t_[0]; wv_[4 * r_ + 1] = t_[1]; wv_[4 * r_ + 2] = t_[2]; wv_[4 * r_ + 3] = t_[3]; } \
          const float bias_ = bgt[(dir_) * 512 + h * 128 + d_]; \
          _Pragma("unroll") for (int i_ = 0; i_ < 16; ++i_) { const float* z_ = ZL + (16 * cg_ + i_) * 32 + (dir_) * 16; float xg_ = bias_; \
              _Pragma("unroll") for (int r_ = 0; r_ < 16; ++r_) xg_ += z_[r_] * wv_[r_]; \
              g[i_] = logsigf(xg_) * (1.f / 16.f); } } \
        if ((dir_) == 0) { _Pragma("unroll") for (int i_ = 1; i_ < 16; ++i_) g[i_] += g[i_ - 1]; TOT[(dir_) * 512 + cg_ * 128 + d_] = g[15]; } \
        else { _Pragma("unroll") for (int i_ = 14; i_ >= 0; --i_) g[i_] += g[i_ + 1]; TOT[(dir_) * 512 + cg_ * 128 + d_] = g[0]; } } while (0)
#define GLA_GATES_FIX(dir_, g, ball_) do { const int d_ = tid & 127, cg_ = tid >> 7; float pre_ = 0.f; ball_ = 0.f; \
        _Pragma("unroll") for (int q_ = 0; q_ < 4; ++q_) { const float t_ = TOT[(dir_) * 512 + q_ * 128 + d_]; ball_ += t_; if ((dir_) == 0 ? (q_ < cg_) : (q_ > cg_)) pre_ += t_; } \
        _Pragma("unroll") for (int i_ = 0; i_ < 16; ++i_) g[i_] += pre_; } while (0)
#define GLA_VFRAGS(vf) do { const s16x4 l0_ = att::tr_read<att::v_rd_off(0, 0, 0)>(vrdw), h0_ = att::tr_read<att::v_rd_off(0, 0, 1)>(vrdw), l1_ = att::tr_read<att::v_rd_off(0, 1, 0)>(vrdw), h1_ = att::tr_read<att::v_rd_off(0, 1, 1)>(vrdw); \
        const s16x4 l2_ = att::tr_read<att::v_rd_off(0, 2, 0)>(vrdw), h2_ = att::tr_read<att::v_rd_off(0, 2, 1)>(vrdw), l3_ = att::tr_read<att::v_rd_off(0, 3, 0)>(vrdw), h3_ = att::tr_read<att::v_rd_off(0, 3, 1)>(vrdw); \
        LDS_WAIT(); SBAR(); \
        vf[0] = (bf16x8){l0_[0], l0_[1], l0_[2], l0_[3], h0_[0], h0_[1], h0_[2], h0_[3]}; vf[1] = (bf16x8){l1_[0], l1_[1], l1_[2], l1_[3], h1_[0], h1_[1], h1_[2], h1_[3]}; \
        vf[2] = (bf16x8){l2_[0], l2_[1], l2_[2], l2_[3], h2_[0], h2_[1], h2_[2], h2_[3]}; vf[3] = (bf16x8){l3_[0], l3_[1], l3_[2], l3_[3], h3_[0], h3_[1], h3_[2], h3_[3]}; } while (0)
#define GLA_LANE() const int r32 = lane & 31, hi = lane >> 5; (void)r32; (void)hi; \
        const int vrdw = (int)(uintptr_t)VL + (wave >> 2) * 16384 + att::v_rd_base(lane) + (wave & 3) * 512

    if (IN(11)) {
        const int lane = opaque_lane(), tid = wave * 64 + lane; (void)tid; (void)lane;
        GLA_LANE();
        for (int it = blk; it < 16 * NPC; it += G) {
            const int bh = it / NPC, pc = it % NPC, b = bh >> 2, h = bh & 3;
            const size_t rowb = pc < 4 ? (size_t)TLAT + b * NCTX + 64 * pc : (size_t)b * SEQ + 64 * (pc - 4);
            GLA_STAGE(rowb, false);
            float g0[16], g1[16];
            __syncthreads();
            GLA_GATES_LOCAL(0, g0); GLA_GATES_LOCAL(1, g1);
            bf16x8 vf[4];
            GLA_VFRAGS(vf);
            __syncthreads();
            { const int d = tid & 127, cg = tid >> 7; float ball0, ball1;
              GLA_GATES_FIX(0, g0, ball0); GLA_GATES_FIX(1, g1, ball1);
              unsigned w0[8], w1[8];
#pragma unroll
              for (int p = 0; p < 8; ++p) { const int c = 16 * cg + 2 * p; const float ka = bf2f(KL[c * 136 + d]), kb = bf2f(KL[(c + 1) * 136 + d]);
                  w0[p] = cvt_pk_bf16(ka * __expf(ball0 - g0[2 * p]), kb * __expf(ball0 - g0[2 * p + 1]));
                  w1[p] = cvt_pk_bf16(ka * __expf(ball1 - g1[2 * p]), kb * __expf(ball1 - g1[2 * p + 1])); }
              *(u32x4*)(QL + d * 72 + 16 * cg) = (u32x4){w0[0], w0[1], w0[2], w0[3]}; *(u32x4*)(QL + d * 72 + 16 * cg + 8) = (u32x4){w0[4], w0[5], w0[6], w0[7]};
              *(u32x4*)(QI1 + d * 72 + 16 * cg) = (u32x4){w1[0], w1[1], w1[2], w1[3]}; *(u32x4*)(QI1 + d * 72 + 16 * cg + 8) = (u32x4){w1[4], w1[5], w1[6], w1[7]};
              if (cg == 0) { DEC[((size_t)(bh * 2) * NPC + pc) * 128 + d] = __expf(ball0); DEC[((size_t)(bh * 2 + 1) * NPC + pc) * 128 + d] = __expf(ball1); } }
            __syncthreads();
#pragma unroll
            for (int dir = 0; dir < 2; ++dir) {
                const bf16_t* KST = dir == 0 ? QL : QI1;
                f32x16 acc[4] = {};
#pragma unroll
                for (int ks = 0; ks < 4; ++ks)
#pragma unroll
                    for (int nb = 0; nb < 4; ++nb) { const bf16x8 a = *(const bf16x8*)(KST + (32 * nb + r32) * 72 + 16 * ks + 8 * hi);
                        acc[nb] = __builtin_amdgcn_mfma_f32_32x32x16_bf16(a, vf[ks], acc[nb], 0, 0, 0); }
                bf16_t* dsp = DS + ((size_t)(bh * 2 + dir) * NPC + pc) * 32768 + (size_t)wave * 4096 + lane * 8;
#pragma unroll
                for (int nb = 0; nb < 4; ++nb) { bf16x8 f0, f1; att::pk4_frag<0>(acc[nb], f0); att::pk4_frag<8>(acc[nb], f1);
                    *(bf16x8*)(dsp + (2 * nb) * 512) = f0; *(bf16x8*)(dsp + (2 * nb + 1) * 512) = f1; }
            }
            __syncthreads();
        }
    }
    SEAM(11);

    if (IN(12)) {
        const int lane = opaque_lane(), tid = wave * 64 + lane; (void)tid; (void)lane;
        for (int gid = blk * 512 + tid; gid < 32 * 4096; gid += G * 512) {
            const int seq = gid >> 12, f = gid & 4095, dir = seq & 1;
            const int d0 = 16 * ((f >> 6) & 7) + 8 * ((f >> 5) & 1);
            bf16_t* base = DS + (size_t)seq * NPC * 32768 + f * 8;
            const float* dbase = DEC + (size_t)seq * NPC * 128 + d0;
            float s[8];
#pragma unroll
            for (int i = 0; i < 8; ++i) s[i] = 0.f;
            for (int st0 = 0; st0 < NPC; st0 += 4) {
                u32x4 dv[4]; f32x4 da[4], db[4]; int pcs[4];
#pragma unroll
                for (int u = 0; u < 4; ++u) { const int st = st0 + u; const int pc = dir == 0 ? st : (st < 4 ? 3 - st : 135 - st); pcs[u] = pc;
                    dv[u] = *(const u32x4*)(base + (size_t)pc * 32768); da[u] = *(const f32x4*)(dbase + pc * 128); db[u] = *(const f32x4*)(dbase + pc * 128 + 4); }
#pragma unroll
                for (int u = 0; u < 4; ++u) {
                    if (pcs[u] >= 4) { u32x4 o; o.x = cvt_pk_bf16(s[0], s[1]); o.y = cvt_pk_bf16(s[2], s[3]); o.z = cvt_pk_bf16(s[4], s[5]); o.w = cvt_pk_bf16(s[6], s[7]);
                        *(u32x4*)(base + (size_t)pcs[u] * 32768) = o; }
                    s[0] = da[u][0] * s[0] + bflo(dv[u].x); s[1] = da[u][1] * s[1] + bfhi(dv[u].x); s[2] = da[u][2] * s[2] + bflo(dv[u].y); s[3] = da[u][3] * s[3] + bfhi(dv[u].y);
                    s[4] = db[u][0] * s[4] + bflo(dv[u].z); s[5] = db[u][1] * s[5] + bfhi(dv[u].z); s[6] = db[u][2] * s[6] + bflo(dv[u].w); s[7] = db[u][3] * s[7] + bfhi(dv[u].w);
                }
            }
        }
    }
    SEAM(12);

    if (IN(13)) {
        const int lane = opaque_lane(), tid = wave * 64 + lane; (void)tid; (void)lane;
        GLA_LANE();
        for (int it = blk; it < 16 * 128; it += G) {
            const int bh = it >> 7, n = it & 127, pc = n + 4, b = bh >> 2;
            int h = bh & 3; unsigned rowb32 = (unsigned)(b * SEQ + 64 * n);
            asm volatile("" : "+v"(h), "+v"(rowb32));
            const size_t rowb = rowb32;
            GLA_STAGE(rowb, true);
            float g0[16], g1[16];
            __syncthreads();
            GLA_GATES_LOCAL(0, g0); GLA_GATES_LOCAL(1, g1);
            bf16x8 vf[4];
            GLA_VFRAGS(vf);
            __syncthreads();
            { const int d = tid & 127, cg = tid >> 7; float ball0, ball1;
              GLA_GATES_FIX(0, g0, ball0); GLA_GATES_FIX(1, g1, ball1); (void)ball0; (void)ball1;
#pragma unroll 4
              for (int i = 0; i < 16; ++i) { const int c = 16 * cg + i; const float qv = bf2f(QL[c * 136 + d]), kv = bf2f(KL[c * 136 + d]);
                  QL[c * 136 + d] = (bf16_t)(cvt_pk_bf16(qv * __expf(g0[i]), 0.f) & 0xffffu);  KL[c * 136 + d] = (bf16_t)(cvt_pk_bf16(kv * __expf(-g0[i]), 0.f) & 0xffffu);
                  QI1[c * 136 + d] = (bf16_t)(cvt_pk_bf16(qv * __expf(g1[i]), 0.f) & 0xffffu); KI1[c * 136 + d] = (bf16_t)(cvt_pk_bf16(kv * __expf(-g1[i]), 0.f) & 0xffffu); } }
            __syncthreads();
            { const int dir = wave >> 2, cb = (wave >> 1) & 1, sb = wave & 1;
              const bf16_t* QI = dir == 0 ? QL : QI1; const bf16_t* KI = dir == 0 ? KL : KI1; f32x16 a = {};
#pragma unroll
              for (int ks = 0; ks < 8; ++ks) { const bf16x8 qa = *(const bf16x8*)(QI + (32 * cb + r32) * 136 + 16 * ks + 8 * hi), kb = *(const bf16x8*)(KI + (32 * sb + r32) * 136 + 16 * ks + 8 * hi);
                  a = __builtin_amdgcn_mfma_f32_32x32x16_bf16(qa, kb, a, 0, 0, 0); }
              int ln2 = lane; asm volatile("" : "+v"(ln2));
              const int hi2 = ln2 >> 5, r322 = ln2 & 31;
#pragma unroll
              for (int r = 0; r < 16; ++r) { const int c = 32 * cb + crow(r, hi2), s2 = 32 * sb + r322; const bool keep = dir == 0 ? (s2 <= c) : (s2 >= c);
                  ATT[dir * 4608 + c * 72 + s2] = (bf16_t)(cvt_pk_bf16(keep ? a[r] : 0.f, 0.f) & 0xffffu); } }
            __syncthreads();
            f32x16 o[2] = {};
#pragma unroll
            for (int dir = 0; dir < 2; ++dir) {
                const bf16_t* QI = dir == 0 ? QL : QI1;
                const bf16_t* sg = DS + ((size_t)(bh * 2 + dir) * NPC + pc) * 32768 + (size_t)wave * 4096 + lane * 8;
                bf16x8 sfr[8];
#pragma unroll
                for (int ks = 0; ks < 8; ++ks) sfr[ks] = *(const bf16x8*)(sg + ks * 512);
#pragma unroll
                for (int cb = 0; cb < 2; ++cb) {
#pragma unroll
                    for (int ks = 0; ks < 4; ++ks) { const bf16x8 a = *(const bf16x8*)(ATT + dir * 4608 + (32 * cb + r32) * 72 + 16 * ks + 8 * hi);
                        o[cb] = __builtin_amdgcn_mfma_f32_32x32x16_bf16(a, vf[ks], o[cb], 0, 0, 0); }
#pragma unroll
                    for (int ks = 0; ks < 8; ++ks) { const bf16x8 a = *(const bf16x8*)(QI + (32 * cb + r32) * 136 + 16 * ks + 8 * hi);
                        o[cb] = __builtin_amdgcn_mfma_f32_32x32x16_bf16(a, sfr[ks], o[cb], 0, 0, 0); } }
            }
            __syncthreads();
#pragma unroll
            for (int cb = 0; cb < 2; ++cb)
#pragma unroll
                for (int r = 0; r < 16; ++r) OL[(32 * cb + crow(r, hi)) * 260 + 32 * wave + r32] = o[cb][r];
            __syncthreads();
            const f32x4 nw = *(const f32x4*)(INP(I_GNORM) + 4 * lane);
#pragma unroll 2
            for (int q = 0; q < 8; ++q) { const int c = 8 * wave + q;
                const f32x4 v = *(const f32x4*)(OL + c * 260 + 4 * lane);
                const float ssum = wave_sum(v[0] * v[0] + v[1] * v[1] + v[2] * v[2] + v[3] * v[3]);
                const float rstd = rsqrtf(ssum * (1.f / 256.f) + NORM_EPS);
                const u32x2 rr = *(const u32x2*)(GR + (rowb + c) * 1024 + h * 256 + 4 * lane);
                u32x2 ov; ov.x = cvt_pk_bf16(v[0] * rstd * nw[0] * siluf(bflo(rr.x)), v[1] * rstd * nw[1] * siluf(bfhi(rr.x)));
                ov.y = cvt_pk_bf16(v[2] * rstd * nw[2] * siluf(bflo(rr.y)), v[3] * rstd * nw[3] * siluf(bfhi(rr.y)));
                *(u32x2*)(AO + (rowb + c) * DM + h * 256 + 4 * lane) = ov; }
            __syncthreads();
        }
    }
#undef GLA_STAGE
#undef GLA_LANE
#undef GLA_GATES_LOCAL
#undef GLA_GATES_FIX
#undef GLA_VFRAGS
    SEAM(13);

    if (IN(14)) {
        const int lane = opaque_lane(), tid = wave * 64 + lane; (void)tid; (void)lane;
        pg8::DenseOrder S; S.init(AO, WGOUT, TLAT, 1024, G, blk);
        pg8::EpiPlain E{YB};
        pg8::gemm_phase<pg8::EpiPlain, pg8::DenseOrder, true, true>((LAS unsigned char*)lds, S, E, wave);
    }
    SEAM(14);

    }

    moe_layer<1>(ws, lds, bar, lo, hi_ph, wave, pvar);

#if MK_PROBE_ATT >= 0
    if (lo == 20) {
        const float lam = 0.2f;
        for (int i = 0;; ++i) { const int L = i * G + blk; if (L >= 1024) break;
            const int bh = i * 8 + (blk & 7), qb = blk >> 3, b = bh >> 3, h = bh & 7;
            att::attn_unit<MK_PROBE_ATT>(QB + ((size_t)b * SEQ + qb * 256) * DM + h * 128, KC + (size_t)b * KVLEN * DM + h * 128, VC + (size_t)b * KVLEN * DM + h * 128,
                           XSB16 + ((size_t)b * SEQ + qb * 256) * DM + h * 128, KVLEN, lam, INP(I_DASUBLN), (char*)lds, wave); }
    }
#endif
#if MK_STAMP
    xcd_barrier(bar, tid == 0); STAMP(20); xcd_barrier(bar, tid == 0);
    { const unsigned long long* st = (const unsigned long long*)(ws + 40960);
      const float ta = (float)(st[MK_STAMP_A + 1] - st[MK_STAMP_A]) * 0.01f, tb = (float)(st[MK_STAMP_B + 1] - st[MK_STAMP_B]) * 0.01f;
      float* outp = (float*)INP(23);
      const size_t n1 = (size_t)(tb * 1e4f);
      for (size_t i = (size_t)blk * 512 + tid; i < n1 && i < (size_t)TLAT * DM - 1; i += (size_t)G * 512) outp[i] = 10.f;
      if (blk == 0 && tid == 0) outp[(size_t)TLAT * DM - 1] = 10.f * ta; }
#endif
#undef IN
#undef SEAM
}


#ifndef MK_DEBUG
#define MK_DEBUG 0
#endif
#ifndef MK_DEBUG_CNT
#define MK_DEBUG_CNT 0
#endif
#ifndef MK_DEBUG_SUB
#define MK_DEBUG_SUB 0
#endif
#ifndef MK_DEBUG_MUL
#define MK_DEBUG_MUL 1
#endif
#if MK_DEBUG
__global__ void dbg_check(const void* p, size_t n, int kind, float lim, unsigned code, unsigned* flag) {
    unsigned bad = 0; size_t minidx = 0xFFFFFFFFull, maxidx = 0;
    for (size_t i = (size_t)blockIdx.x * blockDim.x + threadIdx.x; i < n; i += (size_t)gridDim.x * blockDim.x) {
        if (kind == 0) { const float v = bf2f(((const bf16_t*)p)[i]); if (!(fabsf(v) <= lim)) { ++bad; if (i < minidx) minidx = i; if (i > maxidx) maxidx = i; } }
        else if (kind == 1) { const float v = ((const float*)p)[i]; if (!(fabsf(v) <= lim)) ++bad; }
        else { const int v = ((const int*)p)[i]; if (v < 0 || v > (int)lim) ++bad; }
    }
    if (code == 0u) return;
    if (bad) { atomicAdd(flag + 1, bad); atomicCAS(flag, 0u, code); atomicMin(flag + 2, (unsigned)minidx); atomicMax(flag + 3, (unsigned)maxidx); }
}
__global__ void dbg_report(float* out, size_t n, const unsigned* flag) {
    const unsigned f = *flag;
    if (f == 0u) return;
    const unsigned cnt = flag[1];
    float val = 100.f * (float)f;
#if MK_DEBUG_CNT == 1
    val = 100.f * (float)(32 - __clz(cnt));
#elif MK_DEBUG_CNT == 2
    val = 100.f * (float)(1 + (flag[2] / 32768u) % 132u);
#elif MK_DEBUG_CNT == 3
    val = 100.f * (float)(1 + (flag[2] / 32768u) / 132u);
#elif MK_DEBUG_CNT == 4
    val = 100.f * (float)(1 + (flag[3] / 32768u) % 132u);
#elif MK_DEBUG_CNT == 6
    val = 100.f * (float)(1 + ((flag[2] % 32768u) / 128u) % 64u) + 10000.f * (float)(((flag[2] % 32768u) / 128u) / 64u);
#elif MK_DEBUG_CNT == 7
    val = 100.f * (float)(1 + (flag[2] % 128u) % 64u) + 10000.f * (float)((flag[2] % 128u) / 64u);
#elif MK_DEBUG_CNT == 5
    val = 100.f * (float)(1 + (flag[3] / 32768u) / 132u);
#endif
    for (size_t i = (size_t)blockIdx.x * blockDim.x + threadIdx.x; i < n; i += (size_t)gridDim.x * blockDim.x) out[i] = val;
}
#endif

extern "C" void kernel_launch(void* const* d_in, const int* in_sizes, int n_in, void* d_out, int out_size, void* d_ws, size_t ws_size, hipStream_t stream) {
    static int grid = 0;
    if (grid == 0) {
        if (n_in != 23 || out_size != TLAT * DM || ws_size < WS_END) { fprintf(stderr, "kernel_launch: unexpected shapes (n_in %d, out %d, ws %zu, need %zu)\n", n_in, out_size, ws_size, (size_t)WS_END); grid = -1; return; }
        int dev = 0, cus = 0;
        if (hipGetDevice(&dev) != hipSuccess || hipDeviceGetAttribute(&cus, hipDeviceAttributeMultiprocessorCount, dev) != hipSuccess) { grid = -1; return; }
        if (hipFuncSetAttribute((const void*)fwd_kernel, hipFuncAttributeMaxDynamicSharedMemorySize, LDS_BYTES) != hipSuccess) { fprintf(stderr, "kernel_launch: hipFuncSetAttribute failed\n"); grid = -1; return; }
        int per_cu = 0;
        if (hipOccupancyMaxActiveBlocksPerMultiprocessor(&per_cu, (const void*)fwd_kernel, 512, LDS_BYTES) != hipSuccess || per_cu < 1) { fprintf(stderr, "kernel_launch: occupancy query says %d\n", per_cu); }
        (void)hipGetLastError();
        grid = cus;
        if (grid != 256) fprintf(stderr, "kernel_launch: %d CUs (built for 256)\n", grid);
    }
    if (grid < 0) return;
    (void)hipMemsetAsync((char*)d_ws + WS_CTL, 0, CTL_ZERO_BYTES, stream);
    Args a{};
    for (int i = 0; i < 23; ++i) a.in[i] = (const float*)d_in[i];
    a.out = (float*)d_out; a.ws = (unsigned char*)d_ws;
#if MK_DEBUG
    (void)hipMemsetAsync((char*)d_ws + CTL_ZERO_BYTES, 0xFF, WS_END - CTL_ZERO_BYTES, stream);
    unsigned* flag = (unsigned*)((char*)d_ws + 32768);
    (void)hipMemsetAsync((char*)d_ws + 32768 + 8, 0xFF, 4, stream);
    unsigned char* w = (unsigned char*)d_ws;
#define CHK(ptr, n, kind, lim, code) hipLaunchKernelGGL(dbg_check, dim3(1024), dim3(256), 0, stream, (const void*)(ptr), (size_t)(n), kind, (float)(lim), (unsigned)(MK_DEBUG_SUB ? ((code) - c + 1) * ((p) == MK_DEBUG_SUB - 1) : c), flag)
    for (int p = 0; p < MK_MAX_PHASE; ++p) { a.ph_lo = p; a.ph_hi = p + 1; hipLaunchKernelGGL(fwd_kernel, dim3(grid), dim3(512), LDS_BYTES, stream, a);
        const int c = (p + 1) * MK_DEBUG_MUL;
        switch (p) {
        case 0: CHK(w + WS_MOD, 2 * 5 * 6144, 1, 1e4, c); CHK(w + WS_ROPE, 4096, 1, 1.01, c + 1); CHK(w + WS_WQKV, 3072 * 1024, 0, 1e3, c + 2); CHK(w + WS_WO, 1024 * 1024, 0, 1e3, c + 2); CHK(w + WS_WGIN, GIN_NP * 1024, 0, 1e3, c + 3); CHK(w + WS_WGOUT, 1024 * 1024, 0, 1e3, c + 3);
                CHK(w + WS_WGU, (size_t)64 * 2048 * 1024, 0, 1e3, c + 4); CHK(w + WS_WD, (size_t)64 * 1024 * 1024, 0, 1e3, c + 4); break;
        case 1: CHK(w + WS_T, (size_t)T0 * DM, 0, 1e4, c); break;
        case 2: CHK(w + WS_Q, (size_t)T0 * DM, 0, 1e4, c); CHK(w + WS_KC, (size_t)T0 * DM, 0, 1e4, c + 1); CHK(w + WS_VC, (size_t)T0 * DM, 0, 1e4, c + 2); break;
        case 3: CHK(w + WS_AO, (size_t)T0 * DM, 0, 1e3, c); break;
        case 4: CHK(w + WS_Y, (size_t)T0 * DM, 0, 1e4, c); break;
        case 5: CHK(w + WS_X1, (size_t)T0 * DM, 0, 1e3, c); CHK(w + WS_U, (size_t)T0 * DM, 0, 1e4, c + 1); CHK(w + WS_TOKG, (size_t)T0 * 4, 1, 1.01, c + 2); CHK(w + WS_TOKE, (size_t)T0 * 4, 2, 31, c + 3); CHK(w + WS_HIST, 256 * 32, 2, 600, c + 4); break;
        case 6: CHK(w + WS_TOKR, (size_t)T0 * 4, 2, MAXRB * 256 - 1, c); CHK(w + WS_BLKEXP + 4092, 1, 2, MAXRB, c + 1); break;
        case 9: CHK(w + WS_X2, (size_t)T0 * DM, 0, 1e3, c); CHK(w + WS_T, (size_t)T0 * DM, 0, 1e4, c + 1); break;
        case 10: CHK(w + WS_Q, (size_t)T0 * DM, 0, 1e4, c); CHK(w + WS_KC, (size_t)T0 * DM, 0, 1e4, c + 1); CHK(w + WS_VC, (size_t)T0 * DM, 0, 1e4, c + 2); CHK(w + WS_GZ, (size_t)T0 * 32, 1, 1e4, c + 3); break;
        case 11: CHK(w + WS_H, (size_t)32 * NPC * 256 * 128, 0, 1e5, c); CHK(w + WS_DEC, (size_t)32 * NPC * 128, 1, 1.01, c + 1); break;
        case 12: CHK(w + WS_H, (size_t)32 * NPC * 256 * 128, 0, 1e6, c); break;
        case 13: CHK(w + WS_AO, (size_t)TLAT * DM, 0, 1e4, c); break;
        case 14: CHK(w + WS_Y, (size_t)TLAT * DM, 0, 1e4, c); break;
        case 15: CHK(w + WS_X1, (size_t)TLAT * DM, 0, 1e3, c); CHK(w + WS_U, (size_t)TLAT * DM, 0, 1e4, c + 1); CHK(w + WS_TOKG, (size_t)TLAT * 4, 1, 1.01, c + 2); CHK(w + WS_TOKE, (size_t)TLAT * 4, 2, 31, c + 3); CHK(w + WS_HIST, 256 * 32, 2, 600, c + 4); break;
        case 16: CHK(w + WS_TOKR, (size_t)TLAT * 4, 2, MAXRB * 256 - 1, c); CHK(w + WS_BLKEXP + 4092, 1, 2, MAXRB, c + 1); break;
        case 19: CHK(d_out, (size_t)TLAT * DM, 1, 1e3, c); break;
        default: break;
        }
    }
    hipLaunchKernelGGL(dbg_report, dim3(1024), dim3(256), 0, stream, (float*)d_out, (size_t)TLAT * DM, (const unsigned*)flag);
#elif MK_PER_PHASE
    for (int p = 0; p < MK_MAX_PHASE; ++p) { a.ph_lo = p; a.ph_hi = p + 1; if (p == MK_PVAR_PH) { for (int rep = 0; rep < 2; ++rep) { a.ph_lo = p | (MK_PVAR << 8); hipLaunchKernelGGL(fwd_kernel, dim3(grid), dim3(512), LDS_BYTES, stream, a); } a.ph_lo = p; }
        for (int rep = 0; rep < ((p == MK_REP_PH) ? 1 + MK_REP_N : 1); ++rep) hipLaunchKernelGGL(fwd_kernel, dim3(grid), dim3(512), LDS_BYTES, stream, a);
        if (MK_PROBE_ATT >= 0 && p == 3) { a.ph_lo = 20; a.ph_hi = 21; hipLaunchKernelGGL(fwd_kernel, dim3(grid), dim3(512), LDS_BYTES, stream, a); } }
#else
    a.ph_lo = 0; a.ph_hi = NPHASE;
    hipLaunchKernelGGL(fwd_kernel, dim3(grid), dim3(512), LDS_BYTES, stream, a);
#endif
    const hipError_t le = hipPeekAtLastError();
    if (le != hipSuccess) fprintf(stderr, "kernel_launch: launch failed: %s\n", hipGetErrorName(le));
}
```

```cpp
#include <hip/hip_runtime.h>
#include <cstdio>
#include <cstdint>

#ifndef MK_MAX_PHASE
#define MK_MAX_PHASE 20
#endif
#ifndef MK_PROBE_ATT
#define MK_PROBE_ATT -1
#endif
#ifndef MK_PVAR_PH
#define MK_PVAR_PH -1
#endif
#ifndef MK_PVAR
#define MK_PVAR 0
#endif
#ifndef MK_REP_PH
#define MK_REP_PH -1
#endif
#ifndef MK_REP_N
#define MK_REP_N 2
#endif
#ifndef MK_PER_PHASE
#define MK_PER_PHASE 0
#endif

#define LAS __attribute__((address_space(3)))
typedef unsigned short bf16_t;
typedef short bf16x8 __attribute__((ext_vector_type(8)));
typedef short s16x4 __attribute__((ext_vector_type(4)));
typedef float f32x2 __attribute__((ext_vector_type(2)));
typedef float f32x4 __attribute__((ext_vector_type(4)));
typedef float f32x16 __attribute__((ext_vector_type(16)));
typedef unsigned u32x2 __attribute__((ext_vector_type(2)));
typedef unsigned u32x4 __attribute__((ext_vector_type(4)));

constexpr int DM = 1024, NB = 4, SEQ = 8192, NCTX = 256;
constexpr int TLAT = NB * SEQ, TCTX = NB * NCTX, T0 = TLAT + TCTX;
constexpr int KVLEN = NCTX + SEQ;
constexpr int NEXP = 32, TOPK = 4;
constexpr int MAXRB = 560;
constexpr int GIN_N = 3104, GIN_NP = 3328;
constexpr int NPC = 132;
constexpr float ALPHA = 1.4142135623730951f;
constexpr float NORM_EPS = 1e-5f;
constexpr float QSCALE = 0.125f * 1.4426950408889634f;
constexpr float LAM_INIT0 = 0.2f;
constexpr int NPHASE = 20;

constexpr size_t MiB = 1u << 20;
constexpr size_t WS_CTL = 0;
constexpr size_t CTL_ZERO_BYTES = 64 * 1024;
constexpr size_t WS_MOD = 1 * MiB;
constexpr size_t WS_ROPE = WS_MOD + 256 * 1024;
constexpr size_t WS_HIST = WS_ROPE + 16 * 1024;
constexpr size_t WS_BLKEXP = WS_HIST + 32 * 1024;
constexpr size_t WS_WGT = WS_BLKEXP + 4096;
constexpr size_t WS_TOKE = 2 * MiB;
constexpr size_t WS_TOKG = WS_TOKE + 1 * MiB;
constexpr size_t WS_TOKR = WS_TOKG + 1 * MiB;
constexpr size_t WS_ROWTOK = 5 * MiB;
constexpr size_t WS_GZ = 6 * MiB;
constexpr size_t WS_DEC = 11 * MiB;
constexpr size_t WS_WQKV = 14 * MiB;
constexpr size_t WS_WO = WS_WQKV + 6 * MiB;
constexpr size_t WS_WGIN = WS_WO + 2 * MiB;
constexpr size_t WS_WGOUT = WS_WGIN + 7 * MiB;
constexpr size_t WS_WGU = 32 * MiB;
constexpr size_t WS_WD = WS_WGU + 256 * MiB;
constexpr size_t ACT = (size_t)T0 * DM * 2;
constexpr size_t WS_T = WS_WD + 128 * MiB;
constexpr size_t WS_Q = WS_T + ACT;
constexpr size_t WS_KC = WS_Q + ACT;
constexpr size_t WS_VC = WS_KC + ACT;
constexpr size_t WS_AO = WS_VC + ACT;
constexpr size_t WS_Y = WS_AO + ACT;
constexpr size_t WS_U = WS_Y + ACT;
constexpr size_t WS_X1 = WS_U + ACT;
constexpr size_t WS_X2 = WS_X1 + 2 * ACT;
constexpr size_t XSB = (size_t)MAXRB * 256 * DM * 2;
constexpr size_t WS_XS = WS_X2 + 2 * ACT;
constexpr size_t WS_H = WS_XS + XSB;
constexpr size_t WS_END = WS_H + XSB;

constexpr int LDS_MAIN = 131072;
constexpr int LDS_MISC = 147456;
constexpr int LDS_BYTES = LDS_MISC + 8192;

typedef __bf16 bf16x2_t __attribute__((ext_vector_type(2)));
__device__ __forceinline__ unsigned cvt_pk_bf16(float lo, float hi) { const f32x2 v = {lo, hi}; const bf16x2_t b = __builtin_convertvector(v, bf16x2_t); return __builtin_bit_cast(unsigned, b); }
__device__ __forceinline__ float bf2f(unsigned short b) { return __builtin_bit_cast(float, (unsigned)b << 16); }
__device__ __forceinline__ float bflo(unsigned w) { return __builtin_bit_cast(float, w << 16); }
__device__ __forceinline__ float bfhi(unsigned w) { return __builtin_bit_cast(float, w & 0xffff0000u); }
__device__ __forceinline__ f32x4 bf4_f32(u32x2 w) { return (f32x4){bflo(w.x), bfhi(w.x), bflo(w.y), bfhi(w.y)}; }
template <int CTRL> __device__ __forceinline__ float dpp_f(float v) { return __builtin_bit_cast(float, __builtin_amdgcn_update_dpp(0, __builtin_bit_cast(int, v), CTRL, 0xF, 0xF, true)); }
template <int CTRL> __device__ __forceinline__ int dpp_i(int v) { return __builtin_amdgcn_update_dpp(0, v, CTRL, 0xF, 0xF, true); }
__device__ __forceinline__ float rl_f(float v, int l) { return __builtin_bit_cast(float, __builtin_amdgcn_readlane(__builtin_bit_cast(int, v), l)); }
__device__ __forceinline__ float row16_sum(float v) { v += dpp_f<0xB1>(v); v += dpp_f<0x4E>(v); v += dpp_f<0x141>(v); v += dpp_f<0x140>(v); return v; }
__device__ __forceinline__ float row16_max(float v) { v = fmaxf(v, dpp_f<0xB1>(v)); v = fmaxf(v, dpp_f<0x4E>(v)); v = fmaxf(v, dpp_f<0x141>(v)); v = fmaxf(v, dpp_f<0x140>(v)); return v; }
__device__ __forceinline__ int row16_min(int v) { v = min(v, dpp_i<0xB1>(v)); v = min(v, dpp_i<0x4E>(v)); v = min(v, dpp_i<0x141>(v)); v = min(v, dpp_i<0x140>(v)); return v; }
__device__ __forceinline__ float wave_sum(float v) { v = row16_sum(v); return (rl_f(v, 0) + rl_f(v, 16)) + (rl_f(v, 32) + rl_f(v, 48)); }
__device__ __forceinline__ float half32_sum(float v) { v = row16_sum(v); return v + __builtin_bit_cast(float, __builtin_amdgcn_ds_swizzle(__builtin_bit_cast(int, v), 0x401F)); }
__device__ __forceinline__ float half_max(float v, int hh) { v = row16_max(v); const float a = fmaxf(rl_f(v, 0), rl_f(v, 16)), b = fmaxf(rl_f(v, 32), rl_f(v, 48)); return hh ? b : a; }
__device__ __forceinline__ int half_min(int v, int hh) { v = row16_min(v); const int a = min(__builtin_amdgcn_readlane(v, 0), __builtin_amdgcn_readlane(v, 16)), b = min(__builtin_amdgcn_readlane(v, 32), __builtin_amdgcn_readlane(v, 48)); return hh ? b : a; }
__device__ __forceinline__ float siluf(float x) { return x / (1.f + __expf(-x)); }
__device__ __forceinline__ float logsigf(float x) { return fminf(x, 0.f) - __logf(1.f + __expf(-fabsf(x))); }
__device__ __forceinline__ int crow(int r, int hi) { return (r & 3) + 8 * (r >> 2) + 4 * hi; }
#define LDS_WAIT() asm volatile("s_waitcnt lgkmcnt(0)" ::: "memory")
__device__ __forceinline__ int opaque_lane() { int l; asm volatile("v_mbcnt_lo_u32_b32 %0, -1, 0\n\tv_mbcnt_hi_u32_b32 %0, -1, %0" : "=v"(l)); return l; }
#define SBAR() __builtin_amdgcn_sched_barrier(0)

enum { I_X = 0, I_C, I_CTX, I_CCTX, I_ADAW, I_ADAB, I_LNG, I_LNB, I_DAWIN, I_DAWOUT, I_DALAM, I_DASUBLN, I_GWIN, I_GWGATE, I_GBGATE, I_GNORM, I_GWOUT,
       I_RW, I_RB, I_WGU, I_BGU, I_WD, I_BD };
__device__ __forceinline__ const float* inptr(const unsigned char* lds, int i) {
    const u32x2 v = *(const u32x2*)(lds + LDS_MISC + 64 + 8 * i);
    const unsigned long long p = ((unsigned long long)(unsigned)__builtin_amdgcn_readfirstlane((int)v.y) << 32) | (unsigned)__builtin_amdgcn_readfirstlane((int)v.x);
    return (const float*)p;
}
#define INP(i) inptr(lds, (i))

#define XB_TMO      128
#define XB_XCNT(j)  (256  + 64 * (j))
#define XB_XSUB(j)  (1280 + 64 * (j))
#define XB_XGEN(j)  (2304 + 64 * (j))
#define XB_TOP      3328
#define XB_TOPGEN   3392
#define XCD_BAR_WORDS 3456
#define XB_SPIN_CAP (1u << 18)
__device__ __forceinline__ unsigned xb_ld(unsigned* p)              { return __hip_atomic_load(p, __ATOMIC_RELAXED, __HIP_MEMORY_SCOPE_AGENT); }
__device__ __forceinline__ unsigned xb_add(unsigned* p, unsigned v) { return __hip_atomic_fetch_add(p, v, __ATOMIC_RELAXED, __HIP_MEMORY_SCOPE_AGENT); }
__device__ __forceinline__ unsigned xb_xcc_id() { return (unsigned)__builtin_amdgcn_s_getreg((3 << 11) | 20) & 0xFu; }
#define XB_SPIN(cond, bar) do { unsigned _sp = 0; while (cond) { __builtin_amdgcn_s_sleep(1); \
    if ((++_sp & 255u) == 0u) { if (xb_ld(&(bar)[XB_TMO])) break; if (_sp > XB_SPIN_CAP) { atomicAdd(&(bar)[XB_TMO], 1u); break; } } } } while (0)
struct XcdBarrier { unsigned* bar; unsigned x; volatile LAS unsigned* st; };
__device__ __forceinline__ XcdBarrier xcd_barrier_post(unsigned* bar, volatile LAS unsigned* st, bool leader  ) {
    XcdBarrier b; b.bar = bar; b.x = xb_xcc_id(); b.st = st;
    if (leader) (void)xb_add(&bar[XB_XCNT(b.x)], 1u);
    return b;
}
__device__ __forceinline__ void xcd_barrier_complete(unsigned* bar, unsigned x, unsigned& nloc, unsigned& nx) {
    const unsigned G = gridDim.x * gridDim.y * gridDim.z;
    unsigned sum, cnt, mine, sp = 0u;
    for (;;) {
        sum = 0u; cnt = 0u; mine = 0u;
#pragma unroll
        for (unsigned j = 0; j < 16; ++j) { const unsigned c = xb_ld(&bar[XB_XCNT(j)]); sum += c; cnt += (c > 0u) ? 1u : 0u; mine = (j == x) ? c : mine; }
        if (sum == G) break;
        __builtin_amdgcn_s_sleep(1);
        if ((++sp & 255u) == 0u) { if (xb_ld(&bar[XB_TMO])) break; if (sp > XB_SPIN_CAP) { atomicAdd(&bar[XB_TMO], 1u); break; } }
    }
    nloc = mine > 0u ? mine : 1u; nx = cnt > 0u ? cnt : 1u;
}
__device__ __forceinline__ void xcd_barrier(const XcdBarrier& b, bool leader) {
    asm volatile("s_waitcnt vmcnt(0)" ::: "memory");
    __syncthreads();
    if (leader) {
        unsigned* bar = b.bar;
        __builtin_amdgcn_s_waitcnt(0);
        unsigned nloc = b.st[0], nx = b.st[1];
        if (nloc == 0u) { xcd_barrier_complete(bar, b.x, nloc, nx); b.st[0] = nloc; b.st[1] = nx; }
        const unsigned old = xb_add(&bar[XB_XSUB(b.x)], 1u);
        const unsigned gen = old / nloc;
        if (old + 1u == (gen + 1u) * nloc) {
            __builtin_amdgcn_fence(__ATOMIC_RELEASE, "agent");
            asm volatile("s_waitcnt vmcnt(0)" ::: "memory");
            const unsigned og = xb_add(&bar[XB_TOP], 1u);
            const unsigned tg = og / nx;
            if (og + 1u == (tg + 1u) * nx) xb_add(&bar[XB_TOPGEN], 1u);
            else XB_SPIN(xb_ld(&bar[XB_TOPGEN]) == tg, bar);
            __builtin_amdgcn_fence(__ATOMIC_ACQUIRE, "agent");
            xb_add(&bar[XB_XGEN(b.x)], 1u);
            asm volatile("s_waitcnt vmcnt(0)" ::: "memory");
        } else {
            XB_SPIN(xb_ld(&bar[XB_XGEN(b.x)]) == gen, bar);
            __builtin_amdgcn_fence(__ATOMIC_ACQUIRE, "agent");
            asm volatile("s_waitcnt vmcnt(0)" ::: "memory");
        }
    }
    __syncthreads();
}

namespace pg8 {
constexpr int BM = 256, BK = 64, HALF = 128, HTB = HALF * BK * 2, STAGE_BYTES = 8 * HTB, NXCD = 8, WGM = 8, K = 1024;
typedef int v4i __attribute__((ext_vector_type(4)));
typedef int v8i __attribute__((ext_vector_type(8)));
__host__ __device__ __forceinline__ int lds_byte(int r, int c) { const int st = (r >> 4) * 2 + (c >> 5), rr = r & 15, cc = c & 31, ob = rr * 64 + cc * 2; return st * 1024 + (ob ^ (((ob >> 9) & 1) << 5)); }
__host__ __device__ __forceinline__ void stage_rc(int b, int& R, int& C) { const int st = b / 1024, sb = b % 1024, swz = sb ^ (((sb >> 9) & 1) << 5); R = (st >> 1) * 16 + swz / 64; C = (st & 1) * 32 + (swz % 64) / 2; }
__host__ __device__ __forceinline__ int perm32(int rho) { const int n = rho >> 4, i = rho & 15; return 8 * (i >> 2) + 4 * n + (i & 3); }
struct Unit { int pm, pn, e; };
constexpr size_t TSTEP = (size_t)BM * K * 2;

struct DenseOrder {
    const char* A; const char* Bt; int nM, nN, nwg, G, c; unsigned tstep;
    __device__ void init(const void* A_, const void* Bt_, int M, int N, int G_, int c_, int eb_ = 2) { A = (const char*)A_; Bt = (const char*)Bt_; nM = M / BM; nN = N / BM; nwg = nM * nN; G = G_; c = c_; tstep = (unsigned)(BM * K * eb_); }
    __device__ bool next(int i, Unit& u) const {
        const int L = i * G + c; if (L >= nwg) return false;
        int wgid = L; { const int q = nwg / NXCD, r = nwg % NXCD, xcd = wgid % NXCD, off = wgid / NXCD; wgid = (xcd < r ? xcd * (q + 1) : r * (q + 1) + (xcd - r) * q) + off; }
        const int nig = WGM * nN, gid = wgid / nig, fm = gid * WGM, gsz = (nM - fm) < WGM ? (nM - fm) : WGM;
        u.pm = fm + ((wgid % nig) % gsz); u.pn = (wgid % nig) / gsz; u.e = 0; return true;
    }
    __device__ __forceinline__ unsigned a_off(const Unit& u) const { return (unsigned)u.pm * tstep; }
    __device__ __forceinline__ unsigned b_off(const Unit& u) const { return (unsigned)u.pn * tstep; }
};
#ifndef MOE_XCD_ORDER
#define MOE_XCD_ORDER 0
#endif
struct MoeOrder {
    const char* A; const char* Bt; const int* blkexp; int ncol, nunits, G, c; unsigned tstep;
    int f0, f1, f2, f3, c0, c1, c2, c3;
    __device__ void init(const void* A_, const void* Bt_, const int* blkexp_, int nblk, int ncol_, int G_, int c_, int eb_ = 2) { A = (const char*)A_; Bt = (const char*)Bt_; blkexp = blkexp_; ncol = ncol_; nunits = nblk * ncol_; G = G_; c = c_; tstep = (unsigned)(BM * K * eb_);
#if MOE_XCD_ORDER
        { const int e = c_ & 7;
          f0 = __builtin_amdgcn_readfirstlane(blkexp_[600 + e]); f1 = __builtin_amdgcn_readfirstlane(blkexp_[608 + e]); f2 = __builtin_amdgcn_readfirstlane(blkexp_[616 + e]); f3 = __builtin_amdgcn_readfirstlane(blkexp_[624 + e]);
          c0 = __builtin_amdgcn_readfirstlane(blkexp_[640 + e]) * ncol_; c1 = __builtin_amdgcn_readfirstlane(blkexp_[648 + e]) * ncol_; c2 = __builtin_amdgcn_readfirstlane(blkexp_[656 + e]) * ncol_; c3 = __builtin_amdgcn_readfirstlane(blkexp_[664 + e]) * ncol_; }
#endif
    }
    __device__ bool next(int i, Unit& u) const {
#if MOE_XCD_ORDER
        if ((G & 7) == 0) {
            int idx = i * (G >> 3) + (c >> 3);
            int fj, ej = c & 7;
            if (idx < c0) fj = f0; else { idx -= c0; ej += 8; if (idx < c1) fj = f1; else { idx -= c1; ej += 8; if (idx < c2) fj = f2; else { idx -= c2; ej += 8; if (idx < c3) fj = f3; else return false; } } }
            u.pm = fj + idx / ncol; u.pn = idx % ncol; u.e = ej; return true;
        }
#endif
        const int L = i * G + c; if (L >= nunits) return false;
        u.pm = L / ncol; u.pn = L % ncol; u.e = __builtin_amdgcn_readfirstlane(blkexp[u.pm]); return true;
    }
    __device__ __forceinline__ unsigned a_off(const Unit& u) const { return (unsigned)u.pm * tstep; }
    __device__ __forceinline__ unsigned b_off(const Unit& u) const { return (unsigned)(u.e * ncol + u.pn) * tstep; }
};

template <class Epi, class Sched, bool ALIGN_EPI, bool SP2, int EB = 2, bool GATHER = false>
__device__ __forceinline__ void gemm_phase(LAS unsigned char* lds, const Sched& S, const Epi& E, const int wid  , const unsigned* rowoff = nullptr) {
    static_assert(!GATHER || SP2, "the gathered A path is written for the SP2 schedule");
    const int lane = opaque_lane(), tid = wid * 64 + lane, wr = wid >> 2, wc = wid & 3, fr = lane & 15, fq = lane >> 4;
    constexpr int ROWB = K * EB;
    constexpr int nt = ROWB / 128;
    unsigned voffA[2], voffB[2];
#pragma unroll
    for (int i = 0; i < 2; ++i) { int R, C; stage_rc(tid * 16 + i * 8192, R, C); const int Rb = (R & ~31) + perm32(R & 31);
        voffA[i] = (unsigned)(R * ROWB + C * 2); voffB[i] = (unsigned)(Rb * ROWB + C * 2); }
    constexpr unsigned kstep = (unsigned)(BK * 2);
    constexpr unsigned hstep = (unsigned)(HALF * ROWB);
    constexpr unsigned hsA = GATHER ? 0u : hstep;
    constexpr int GT_BASE = 131072;
    unsigned cofA = 0u; LAS unsigned char* gtl = lds;
    const __amdgpu_buffer_rsrc_t rsrcT = __builtin_amdgcn_make_buffer_rsrc((void*)(GATHER ? (const void*)rowoff : (const void*)S.A), 0, 0x7fffffff, 0x00020000);
    if constexpr (GATHER) { const int lz_ = opaque_lane(); int R_, C_; stage_rc((wid * 64 + lz_) * 16, R_, C_); cofA = (unsigned)(C_ * 2); gtl = lds + GT_BASE + wid * 2048 + lz_ * 4; }
#define PG8_TOKDMA(pm_, SLOT_) do { const int lq_ = opaque_lane(); int Rq_, Cq_; stage_rc((wid * 64 + lq_) * 16, Rq_, Cq_); (void)Cq_; _Pragma("unroll") for (int e_ = 0; e_ < 4; ++e_) \
        __builtin_amdgcn_raw_ptr_buffer_load_lds(rsrcT, (LAS void*)(lds + GT_BASE + wid * 2048 + (SLOT_) + e_ * 256), 4, Rq_ * 4, ((pm_) * 256 + e_ * 64) * 4, 0, 0); } while (0)
#define PG8_AOFF(dst, SLOT_, H_) do { dst[0] = *(const LAS unsigned*)(gtl + (SLOT_) + (H_) * 512) + cofA; dst[1] = *(const LAS unsigned*)(gtl + (SLOT_) + (H_) * 512 + 256) + cofA; } while (0)
    const unsigned ldsw = (unsigned)wid * 1024u;
    const int aoff = lds_byte(wr * 64 + fr, fq * 8), boff = lds_byte(wc * 32 + fr, fq * 8);
#define PG8_SA(b, h) (((b) * 2 + (h)) * HTB)
#define PG8_SB(b, h) ((4 + (b) * 2 + (h)) * HTB)
    const __amdgpu_buffer_rsrc_t rsrcA = __builtin_amdgcn_make_buffer_rsrc((void*)S.A, 0, 0x7fffffff, 0x00020000), rsrcB = __builtin_amdgcn_make_buffer_rsrc((void*)S.Bt, 0, 0x7fffffff, 0x00020000);
#define PG8_STAGE(bufoff, rs, soff, voff) do { _Pragma("unroll") for (int _i = 0; _i < 2; ++_i) \
        __builtin_amdgcn_raw_ptr_buffer_load_lds(rs, (LAS void*)(lds + (bufoff) + ldsw + _i * 8192), 16, (int)(voff)[_i], (int)(soff), 0, 0); } while (0)
#define PG8_LDA(dst, b, h) do { _Pragma("unroll") for (int m = 0; m < 4; ++m) { const v4i lo_ = *(const LAS v4i*)(lds + PG8_SA(b, h) + aoff + m * 2048), hi_ = *(const LAS v4i*)(lds + PG8_SA(b, h) + aoff + m * 2048 + 1024); \
        dst[m] = __builtin_shufflevector(lo_, hi_, 0, 1, 2, 3, 4, 5, 6, 7); } } while (0)
#define PG8_LDB(dst, b, h) do { _Pragma("unroll") for (int n = 0; n < 2; ++n) { const v4i lo_ = *(const LAS v4i*)(lds + PG8_SB(b, h) + boff + n * 2048), hi_ = *(const LAS v4i*)(lds + PG8_SB(b, h) + boff + n * 2048 + 1024); \
        dst[n] = __builtin_shufflevector(lo_, hi_, 0, 1, 2, 3, 4, 5, 6, 7); } } while (0)
#define PG8_HALF(v_, k_) __builtin_bit_cast(bf16x8, __builtin_shufflevector(v_, v_, 4 * (k_), 4 * (k_) + 1, 4 * (k_) + 2, 4 * (k_) + 3))
#define PG8_MMA(ai, bj, At, Bt) do { __builtin_amdgcn_s_setprio(1); _Pragma("unroll") for (int m = 0; m < 4; ++m) _Pragma("unroll") for (int n = 0; n < 2; ++n) { \
        if constexpr (EB == 1) acc[ai][bj][m][n] = __builtin_amdgcn_mfma_scale_f32_16x16x128_f8f6f4(Bt[n], At[m], acc[ai][bj][m][n], 0, 0, 0, 0x7F7F7F7F, 0, 0x7F7F7F7F); \
        else { acc[ai][bj][m][n] = __builtin_amdgcn_mfma_f32_16x16x32_bf16(PG8_HALF(Bt[n], 0), PG8_HALF(At[m], 0), acc[ai][bj][m][n], 0, 0, 0); \
               acc[ai][bj][m][n] = __builtin_amdgcn_mfma_f32_16x16x32_bf16(PG8_HALF(Bt[n], 1), PG8_HALF(At[m], 1), acc[ai][bj][m][n], 0, 0, 0); } } \
        __builtin_amdgcn_s_setprio(0); } while (0)
#define PG8_WAIT_V(n) asm volatile("s_waitcnt vmcnt(" #n ")" ::: "memory")
#define PG8_WAIT_L(n) asm volatile("s_waitcnt lgkmcnt(" #n ")" ::: "memory")
#define PG8_BAR __builtin_amdgcn_s_barrier()
#define PG8_SCHED __builtin_amdgcn_sched_barrier(0)
    Unit cur, nxt; int ui = 0;
    if (!S.next(0, cur)) return;
    f32x4 acc[2][2][4][2];
#pragma unroll
    for (int a = 0; a < 2; ++a)
#pragma unroll
        for (int b = 0; b < 2; ++b)
#pragma unroll
            for (int m = 0; m < 4; ++m)
#pragma unroll
                for (int n = 0; n < 2; ++n) acc[a][b][m][n] = (f32x4){0.f, 0.f, 0.f, 0.f};
    v8i At[4], B0[2], B1[2];
    unsigned cA = GATHER ? 0u : S.a_off(cur), cB = S.b_off(cur);
    if constexpr (SP2) {
        unsigned w0_[2], w1_[2]; w0_[0] = w1_[0] = voffA[0]; w0_[1] = w1_[1] = voffA[1];
        if constexpr (GATHER) { PG8_TOKDMA(cur.pm, 0); { Unit n1_; if (S.next(1, n1_)) PG8_TOKDMA(n1_.pm, 1024); } PG8_WAIT_V(0); PG8_AOFF(w0_, 0, 0); PG8_AOFF(w1_, 0, 1); }
        PG8_STAGE(PG8_SB(0, 0), rsrcB, cB, voffB); PG8_STAGE(PG8_SB(0, 1), rsrcB, cB + hstep, voffB); PG8_STAGE(PG8_SA(0, 0), rsrcA, cA, w0_); PG8_STAGE(PG8_SA(0, 1), rsrcA, cA + hsA, w1_);
        if (wr == 1) PG8_BAR;
        PG8_WAIT_V(2); PG8_BAR;
        PG8_STAGE(PG8_SB(1, 0), rsrcB, cB + kstep, voffB); PG8_STAGE(PG8_SA(1, 0), rsrcA, cA + kstep, w0_); PG8_STAGE(PG8_SB(1, 1), rsrcB, cB + hstep + kstep, voffB);
        PG8_WAIT_V(6); PG8_BAR;
    } else {
        PG8_STAGE(PG8_SB(0, 0), rsrcB, cB, voffB); PG8_STAGE(PG8_SA(0, 0), rsrcA, cA, voffA); PG8_STAGE(PG8_SB(0, 1), rsrcB, cB + hstep, voffB); PG8_STAGE(PG8_SA(0, 1), rsrcA, cA + hstep, voffA);
        if (wr == 1) PG8_BAR;
        PG8_WAIT_V(4); PG8_BAR;
        PG8_STAGE(PG8_SB(1, 0), rsrcB, cB + kstep, voffB); PG8_STAGE(PG8_SA(1, 0), rsrcA, cA + kstep, voffA); PG8_STAGE(PG8_SB(1, 1), rsrcB, cB + hstep + kstep, voffB);
        PG8_WAIT_V(6); PG8_BAR;
    }
    for (;;) {
        const bool has_next = S.next(ui + 1, nxt);
        const unsigned nA = GATHER ? 0u : (has_next ? S.a_off(nxt) : cA), nB = has_next ? S.b_off(nxt) : cB;
        const int scur = (ui & 1) * 1024, snxt = scur ^ 1024;
        if constexpr (GATHER) { if (ui > 0 && has_next) PG8_TOKDMA(nxt.pm, snxt); }
        asm volatile(".p2align 8" ::: "memory");
#pragma unroll 1
        for (int t = 0; t < nt; t += 2) {
            const bool last = (t == nt - 2);
            const unsigned a1 = cA + (unsigned)(t + 1) * kstep;
            const unsigned a2 = last ? nA : cA + (unsigned)(t + 2) * kstep, b2 = last ? nB : cB + (unsigned)(t + 2) * kstep;
            const unsigned a3 = a2 + kstep, b3 = b2 + kstep;
            if constexpr (SP2) {
            const int ssel = last ? snxt : scur;
            unsigned wa_[2]; wa_[0] = voffA[0]; wa_[1] = voffA[1];
            if constexpr (GATHER) PG8_AOFF(wa_, scur, 1);
            PG8_LDB(B0, 0, 0); PG8_LDB(B1, 0, 1); PG8_SCHED; PG8_LDA(At, 0, 0); PG8_STAGE(PG8_SA(1, 1), rsrcA, a1 + hsA, wa_);
            if constexpr (GATHER) PG8_AOFF(wa_, ssel, 0);
            PG8_WAIT_V(8); PG8_WAIT_L(0); PG8_BAR; PG8_MMA(0, 0, At, B0); PG8_MMA(0, 1, At, B1); PG8_BAR; PG8_SCHED;
            PG8_LDA(At, 0, 1); PG8_STAGE(PG8_SB(0, 0), rsrcB, b2, voffB); PG8_STAGE(PG8_SB(0, 1), rsrcB, b2 + hstep, voffB); PG8_STAGE(PG8_SA(0, 0), rsrcA, a2, wa_);
            if constexpr (GATHER) PG8_AOFF(wa_, ssel, 1);
            PG8_WAIT_V(8); PG8_WAIT_L(0); PG8_BAR; PG8_MMA(1, 0, At, B0); PG8_MMA(1, 1, At, B1); PG8_BAR; PG8_SCHED;
            PG8_LDB(B0, 1, 0); PG8_LDB(B1, 1, 1); PG8_SCHED; PG8_LDA(At, 1, 0); PG8_STAGE(PG8_SA(0, 1), rsrcA, a2 + hsA, wa_);
            if constexpr (GATHER) PG8_AOFF(wa_, ssel, 0);
            PG8_WAIT_V(8); PG8_WAIT_L(0); PG8_BAR; PG8_MMA(0, 0, At, B0); PG8_MMA(0, 1, At, B1); PG8_BAR; PG8_SCHED;
            PG8_LDA(At, 1, 1); PG8_STAGE(PG8_SB(1, 0), rsrcB, b3, voffB); PG8_STAGE(PG8_SB(1, 1), rsrcB, b3 + hstep, voffB); PG8_STAGE(PG8_SA(1, 0), rsrcA, a3, wa_);
            PG8_WAIT_V(8); PG8_WAIT_L(0); PG8_BAR; PG8_MMA(1, 0, At, B0); PG8_MMA(1, 1, At, B1); PG8_BAR; PG8_SCHED;
            } else {
            PG8_LDB(B0, 0, 0); PG8_SCHED; PG8_LDA(At, 0, 0); PG8_STAGE(PG8_SA(1, 1), rsrcA, a1 + hstep, voffA);
            PG8_WAIT_L(8); PG8_BAR; PG8_WAIT_L(0); PG8_MMA(0, 0, At, B0); PG8_BAR; PG8_SCHED;
            PG8_LDB(B1, 0, 1); PG8_STAGE(PG8_SB(0, 0), rsrcB, b2, voffB);
            PG8_BAR; PG8_WAIT_L(0); PG8_MMA(0, 1, At, B1); PG8_BAR;
            PG8_LDA(At, 0, 1); PG8_STAGE(PG8_SA(0, 0), rsrcA, a2, voffA);
            PG8_BAR; PG8_WAIT_L(0); PG8_MMA(1, 0, At, B0); PG8_BAR; PG8_SCHED;
            PG8_STAGE(PG8_SB(0, 1), rsrcB, b2 + hstep, voffB);
            PG8_WAIT_V(6); PG8_BAR; PG8_MMA(1, 1, At, B1); PG8_BAR;
            PG8_LDB(B0, 1, 0); PG8_SCHED; PG8_LDA(At, 1, 0); PG8_STAGE(PG8_SA(0, 1), rsrcA, a2 + hstep, voffA);
            PG8_WAIT_L(8); PG8_BAR; PG8_WAIT_L(0); PG8_MMA(0, 0, At, B0); PG8_BAR; PG8_SCHED;
            PG8_LDB(B1, 1, 1); PG8_STAGE(PG8_SB(1, 0), rsrcB, b3, voffB);
            PG8_BAR; PG8_WAIT_L(0); PG8_MMA(0, 1, At, B1); PG8_BAR;
            PG8_LDA(At, 1, 1); PG8_STAGE(PG8_SA(1, 0), rsrcA, a3, voffA);
            PG8_BAR; PG8_WAIT_L(0); PG8_MMA(1, 0, At, B0); PG8_BAR; PG8_SCHED;
            PG8_STAGE(PG8_SB(1, 1), rsrcB, b3 + hstep, voffB);
            PG8_WAIT_V(6); PG8_BAR; PG8_MMA(1, 1, At, B1); PG8_BAR;
            }
        }
        if constexpr (ALIGN_EPI) { if (wr == 0) PG8_BAR; }
        { const int lz = opaque_lane();
          E(acc, cur, wid >> 2, wid & 3, lz & 15, lz >> 4); }
        if (!has_next) break;
#pragma unroll
        for (int a = 0; a < 2; ++a)
#pragma unroll
            for (int b = 0; b < 2; ++b)
#pragma unroll
                for (int m = 0; m < 4; ++m)
#pragma unroll
                    for (int n = 0; n < 2; ++n) acc[a][b][m][n] = (f32x4){0.f, 0.f, 0.f, 0.f};
        cur = nxt; cA = nA; cB = nB; ++ui;
        if constexpr (ALIGN_EPI) { if (wr == 1) PG8_BAR; }
    }
    PG8_WAIT_V(0);
    if constexpr (!ALIGN_EPI) { if (wr == 0) PG8_BAR; }
    PG8_BAR;
#undef PG8_SA
#undef PG8_SB
#undef PG8_STAGE
#undef PG8_TOKDMA
#undef PG8_AOFF
#undef PG8_LDA
#undef PG8_LDB
#undef PG8_MMA
#undef PG8_HALF
#undef PG8_WAIT_V
#undef PG8_WAIT_L
#undef PG8_BAR
#undef PG8_SCHED
}

__device__ __forceinline__ void st8bf(bf16_t* p, const f32x4& v0, const f32x4& v1) {
    u32x4 o; o.x = cvt_pk_bf16(v0[0], v0[1]); o.y = cvt_pk_bf16(v0[2], v0[3]); o.z = cvt_pk_bf16(v1[0], v1[1]); o.w = cvt_pk_bf16(v1[2], v1[3]);
    *(u32x4*)p = o;
}

constexpr float QKV_SCALE = 32.f;
constexpr float AO_SCALE = 4.f, WO_SCALE = 64.f, GIN_SCALE = 32.f;
struct EpiQKV {
    bf16_t* Q; bf16_t* KC; bf16_t* VC; const float* rope;
    static constexpr float WSC = 1.f / QKV_SCALE;
    __device__ __forceinline__ void operator()(const f32x4 (&acc)[2][2][4][2], const Unit& u, int wr, int wc, int fr, int fq) const {
        const int pm = u.pm, pn = u.pn;
        const bool lat = pm < 128;
        const int b = lat ? (pm >> 5) : (pm - 128);
        const int posb = lat ? ((pm & 31) << 8) : 0;
        const size_t kvrow0 = (size_t)b * KVLEN + (lat ? (NCTX + posb) : 0);
        const size_t qrow0 = (size_t)pm * 256;
        if (pn < 8) {
            const int sec = pn >> 2;
            const int blk = 4 * (pn & 3) + wc;
            const float scl = sec == 0 ? QSCALE * WSC : WSC;
#pragma unroll
            for (int ai = 0; ai < 2; ++ai)
#pragma unroll
                for (int m = 0; m < 4; ++m) {
                    const int lr = 128 * ai + 64 * wr + 16 * m + fr;
                    f32x4 cs0 = {1.f, 0.f, 1.f, 0.f}, cs1 = cs0, cs2 = cs0, cs3 = cs0;
                    if (lat) { const int pos = posb + lr; const int v = (fq < 2) ? (pos >> 6) : (pos & 63);
                        const f32x4* rp = (const f32x4*)(rope + (size_t)(v * 16 + (fq & 1) * 8) * 2);
                        cs0 = rp[0]; cs1 = rp[1]; cs2 = rp[2]; cs3 = rp[3]; }
                    const f32x4 a0 = acc[ai][0][m][0], a1 = acc[ai][0][m][1], b0 = acc[ai][1][m][0], b1 = acc[ai][1][m][1];
                    f32x4 o1a, o1b, o2a, o2b;
                    o1a[0] = (a0[0] * cs0[0] - b0[0] * cs0[1]) * scl; o2a[0] = (a0[0] * cs0[1] + b0[0] * cs0[0]) * scl;
                    o1a[1] = (a0[1] * cs0[2] - b0[1] * cs0[3]) * scl; o2a[1] = (a0[1] * cs0[3] + b0[1] * cs0[2]) * scl;
                    o1a[2] = (a0[2] * cs1[0] - b0[2] * cs1[1]) * scl; o2a[2] = (a0[2] * cs1[1] + b0[2] * cs1[0]) * scl;
                    o1a[3] = (a0[3] * cs1[2] - b0[3] * cs1[3]) * scl; o2a[3] = (a0[3] * cs1[3] + b0[3] * cs1[2]) * scl;
                    o1b[0] = (a1[0] * cs2[0] - b1[0] * cs2[1]) * scl; o2b[0] = (a1[0] * cs2[1] + b1[0] * cs2[0]) * scl;
                    o1b[1] = (a1[1] * cs2[2] - b1[1] * cs2[3]) * scl; o2b[1] = (a1[1] * cs2[3] + b1[1] * cs2[2]) * scl;
                    o1b[2] = (a1[2] * cs3[0] - b1[2] * cs3[1]) * scl; o2b[2] = (a1[2] * cs3[1] + b1[2] * cs3[0]) * scl;
                    o1b[3] = (a1[3] * cs3[2] - b1[3] * cs3[3]) * scl; o2b[3] = (a1[3] * cs3[3] + b1[3] * cs3[2]) * scl;
                    bf16_t* rowp = (sec == 0 ? Q + (qrow0 + lr) * DM : KC + (kvrow0 + lr) * DM) + 64 * blk + 8 * fq;
                    st8bf(rowp, o1a, o1b); st8bf(rowp + 32, o2a, o2b);
                }
        } else {
            const int col0 = 256 * (pn - 8) + 32 * wc + 8 * fq;
#pragma unroll
            for (int ai = 0; ai < 2; ++ai)
#pragma unroll
                for (int m = 0; m < 4; ++m) {
                    const int lr = 128 * ai + 64 * wr + 16 * m + fr;
                    bf16_t* rowp = VC + (kvrow0 + lr) * DM + col0;
                    st8bf(rowp, acc[ai][0][m][0] * WSC, acc[ai][0][m][1] * WSC); st8bf(rowp + 128, acc[ai][1][m][0] * WSC, acc[ai][1][m][1] * WSC);
                }
        }
    }
};
struct EpiPlain {
    bf16_t* O; float sc;
    __device__ __forceinline__ void operator()(const f32x4 (&acc)[2][2][4][2], const Unit& u, int wr, int wc, int fr, int fq) const {
        const int col0 = 256 * u.pn + 32 * wc + 8 * fq;
#pragma unroll
        for (int ai = 0; ai < 2; ++ai)
#pragma unroll
            for (int m = 0; m < 4; ++m) {
                bf16_t* rowp = O + ((size_t)u.pm * 256 + 128 * ai + 64 * wr + 16 * m + fr) * DM + col0;
                st8bf(rowp, acc[ai][0][m][0] * sc, acc[ai][0][m][1] * sc); st8bf(rowp + 128, acc[ai][1][m][0] * sc, acc[ai][1][m][1] * sc);
            }
    }
};
struct EpiGlaIn {
    bf16_t* Gq; bf16_t* Gk; bf16_t* Gv; bf16_t* Gr; float* Gz;
    __device__ __forceinline__ void operator()(const f32x4 (&acc)[2][2][4][2], const Unit& u, int wr, int wc, int fr, int fq) const {
        const int pn = u.pn;
        const size_t row0 = (size_t)u.pm * 256;
        if (pn == 12) {
            if (wc == 0) {
#pragma unroll
                for (int ai = 0; ai < 2; ++ai)
#pragma unroll
                    for (int m = 0; m < 4; ++m) {
                        float* rowp = Gz + (row0 + 128 * ai + 64 * wr + 16 * m + fr) * 32 + 8 * fq;
                        *(f32x4*)rowp = acc[ai][0][m][0] * (1.f / GIN_SCALE); *(f32x4*)(rowp + 4) = acc[ai][0][m][1] * (1.f / GIN_SCALE);
                    }
            }
            return;
        }
        bf16_t* base; int ld, ct; float scl = 1.f / GIN_SCALE;
        if (pn < 2) { base = Gq; ld = 512; ct = pn; scl = 0.08838834764831845f / GIN_SCALE; }
        else if (pn < 4) { base = Gk; ld = 512; ct = pn - 2; }
        else if (pn < 8) { base = Gv; ld = 1024; ct = pn - 4; }
        else { base = Gr; ld = 1024; ct = pn - 8; }
        const int col0 = 256 * ct + 32 * wc + 8 * fq;
#pragma unroll
        for (int ai = 0; ai < 2; ++ai)
#pragma unroll
            for (int m = 0; m < 4; ++m) {
                bf16_t* rowp = base + (row0 + 128 * ai + 64 * wr + 16 * m + fr) * ld + col0;
                st8bf(rowp, acc[ai][0][m][0] * scl, acc[ai][0][m][1] * scl); st8bf(rowp + 128, acc[ai][1][m][0] * scl, acc[ai][1][m][1] * scl);
            }
    }
};
__device__ __forceinline__ unsigned pk4_fp8(float a, float b, float c, float d) { int w = 0; w = __builtin_amdgcn_cvt_pk_fp8_f32(a, b, w, false); w = __builtin_amdgcn_cvt_pk_fp8_f32(c, d, w, true); return (unsigned)w; }
constexpr float WGU_SCALE = 32.f, WD_SCALE = 64.f, H_SCALE = 8.f, Y_SCALE = 16.f;
struct EpiGateUp {
    unsigned char* ws; const unsigned char* lds; int layer;
    __device__ __forceinline__ void operator()(const f32x4 (&acc)[2][2][4][2], const Unit& u, int wr, int wc, int fr, int fq) const {
        unsigned char* H = ws + WS_H; const float* bgu = INP(I_BGU) + (size_t)layer * 32 * 2048;
        const int xc = 128 * u.pn + 32 * wc + 8 * fq;
        const float* bp = bgu + (size_t)u.e * 2048 + xc;
        const f32x4 bg0 = *(const f32x4*)bp, bg1 = *(const f32x4*)(bp + 4), bl0 = *(const f32x4*)(bp + 1024), bl1 = *(const f32x4*)(bp + 1028);
        constexpr float ws = 1.f / WGU_SCALE;
#pragma unroll
        for (int ai = 0; ai < 2; ++ai)
#pragma unroll
            for (int m = 0; m < 4; ++m) {
                f32x4 o0, o1;
#pragma unroll
                for (int i = 0; i < 4; ++i) {
                    float g = fminf(acc[ai][0][m][0][i] * ws + bg0[i], 7.f), l = fminf(fmaxf(acc[ai][1][m][0][i] * ws + bl0[i], -7.f), 7.f);
                    o0[i] = H_SCALE * g * __builtin_amdgcn_rcpf(1.f + __expf(-1.702f * g)) * (l + 1.f);
                    g = fminf(acc[ai][0][m][1][i] * ws + bg1[i], 7.f); l = fminf(fmaxf(acc[ai][1][m][1][i] * ws + bl1[i], -7.f), 7.f);
                    o1[i] = H_SCALE * g * __builtin_amdgcn_rcpf(1.f + __expf(-1.702f * g)) * (l + 1.f);
                }
                u32x2 o; o.x = pk4_fp8(o0[0], o0[1], o0[2], o0[3]); o.y = pk4_fp8(o1[0], o1[1], o1[2], o1[3]);
                *(u32x2*)(H + ((size_t)u.pm * 256 + 128 * ai + 64 * wr + 16 * m + fr) * DM + xc) = o;
            }
    }
};
struct EpiDown {
    unsigned char* ws; const unsigned char* lds; int layer;
    __device__ __forceinline__ void operator()(const f32x4 (&acc)[2][2][4][2], const Unit& u, int wr, int wc, int fr, int fq) const {
        unsigned char* YD = ws + WS_XS; const float* bd = INP(I_BD) + (size_t)layer * 32 * 1024;
        const int col0 = 256 * u.pn + 32 * wc + 8 * fq;
        const float* bp = bd + (size_t)u.e * 1024 + col0;
        const f32x4 b00 = *(const f32x4*)bp, b01 = *(const f32x4*)(bp + 4), b10 = *(const f32x4*)(bp + 128), b11 = *(const f32x4*)(bp + 132);
        constexpr float ws_ = Y_SCALE / (WD_SCALE * H_SCALE);
#pragma unroll
        for (int ai = 0; ai < 2; ++ai)
#pragma unroll
            for (int m = 0; m < 4; ++m) {
                unsigned char* rowp = YD + ((size_t)u.pm * 256 + 128 * ai + 64 * wr + 16 * m + fr) * DM + col0;
                const f32x4 v0 = acc[ai][0][m][0] * ws_ + b00 * Y_SCALE, v1 = acc[ai][0][m][1] * ws_ + b01 * Y_SCALE, v2 = acc[ai][1][m][0] * ws_ + b10 * Y_SCALE, v3 = acc[ai][1][m][1] * ws_ + b11 * Y_SCALE;
                u32x2 o0, o1; o0.x = pk4_fp8(v0[0], v0[1], v0[2], v0[3]); o0.y = pk4_fp8(v1[0], v1[1], v1[2], v1[3]); o1.x = pk4_fp8(v2[0], v2[1], v2[2], v2[3]); o1.y = pk4_fp8(v3[0], v3[1], v3[2], v3[3]);
                *(u32x2*)rowp = o0; *(u32x2*)(rowp + 128) = o1;
            }
    }
};
}

namespace att {
constexpr int NW = 8, QBLK = 32, KVBLK = 64;
constexpr size_t SHM_V = KVBLK * 128 * 2, SHM_K = KVBLK * 128 * 2;

constexpr float THR = 8.f;
#define KSWZ(row, colB) ((row) * 256 + ((colB) ^ (((row) & 15) << 4)))
__device__ __forceinline__ int v_st(int k, int c) { const int kk = (k & ~0xC) | ((k & 4) << 1) | ((k & 8) >> 1); return ((kk >> 3) * 4 + (c >> 5)) * 512 + ((kk & 7) * 32 + (c & 31)) * 2; }
__device__ __forceinline__ int v_rd_base(int lane) { return ((lane & 3) << 3) | (((lane >> 2) & 3) << 6) | (((lane >> 4) & 1) << 5) | (((lane >> 5) & 1) << 8); }
constexpr int v_rd_off(int d0, int ks, int half) { return d0 * 512 + ks * 4096 + half * 2048; }
template <int OFF> __device__ __forceinline__ s16x4 tr_read(int vb) {
    s16x4 r; asm volatile("ds_read_b64_tr_b16 %0, %1 offset:%2" : "=&v"(r) : "v"(vb), "i"(OFF) : "memory"); return r;
}
__device__ __forceinline__ void qkt_map(f32x16& p0, f32x16& p1, const char* Ks, const bf16x8* qs  , int mapB, int r32, int hi) {
    p0 = f32x16{}; p1 = f32x16{};
#pragma unroll
    for (int d0 = 0; d0 < 4; ++d0) { const int cb = mapB + (d0 * 16 + hi * 8) * 2;
        const bf16x8 b0 = *reinterpret_cast<const bf16x8*>(Ks + KSWZ(r32, cb));
        const bf16x8 b1 = *reinterpret_cast<const bf16x8*>(Ks + KSWZ(32 + r32, cb));
        const bf16x8 q = qs[d0 * 64];
        p0 = __builtin_amdgcn_mfma_f32_32x32x16_bf16(b0, q, p0, 0, 0, 0);
        p1 = __builtin_amdgcn_mfma_f32_32x32x16_bf16(b1, q, p1, 0, 0, 0); }
}
__device__ __forceinline__ void softmax_tile(f32x16& p0, f32x16& p1, float& m_reg, float& l_reg, float& alpha, bf16x8& pa0, bf16x8& pa1, bf16x8& pa2, bf16x8& pa3) {
    float pmax = p0[0];
#pragma unroll
    for (int r = 1; r < 16; ++r) pmax = fmaxf(pmax, p0[r]);
#pragma unroll
    for (int r = 0; r < 16; ++r) pmax = fmaxf(pmax, p1[r]);
    { auto rr = __builtin_amdgcn_permlane32_swap(__float_as_uint(pmax), __float_as_uint(pmax), false, false);
      pmax = fmaxf(__uint_as_float(rr[0]), __uint_as_float(rr[1])); }
    float mn;
    if (__builtin_expect(__all(pmax - m_reg <= THR), 1)) { mn = m_reg; alpha = 1.f; }
    else { mn = fmaxf(m_reg, pmax); alpha = __builtin_amdgcn_exp2f(m_reg - mn); m_reg = mn; }
#pragma unroll
    for (int r = 0; r < 16; ++r) p0[r] = __builtin_amdgcn_exp2f(p0[r] - mn);
#pragma unroll
    for (int r = 0; r < 16; ++r) p1[r] = __builtin_amdgcn_exp2f(p1[r] - mn);
    float ps = 0.f;
#pragma unroll
    for (int r = 0; r < 16; ++r) ps += p0[r];
#pragma unroll
    for (int r = 0; r < 16; ++r) ps += p1[r];
    { auto rr = __builtin_amdgcn_permlane32_swap(__float_as_uint(ps), __float_as_uint(ps), false, false);
      ps = __uint_as_float(rr[0]) + __uint_as_float(rr[1]); }
    l_reg = l_reg * alpha + ps;
#define PK4(P, BASE, OUT) do { unsigned a0 = cvt_pk_bf16(P[BASE + 0], P[BASE + 1]), a1 = cvt_pk_bf16(P[BASE + 2], P[BASE + 3]);   \
    unsigned b0 = cvt_pk_bf16(P[BASE + 4], P[BASE + 5]), b1 = cvt_pk_bf16(P[BASE + 6], P[BASE + 7]);                              \
    auto r0 = __builtin_amdgcn_permlane32_swap(a0, b0, false, false); auto r1 = __builtin_amdgcn_permlane32_swap(a1, b1, false, false); \
    u32x4 w = {r0[0], r1[0], r0[1], r1[1]}; OUT = *reinterpret_cast<bf16x8*>(&w); } while (0)
    PK4(p0, 0, pa0); PK4(p0, 8, pa1); PK4(p1, 0, pa2); PK4(p1, 8, pa3);
#undef PK4
}
template <int BASE> __device__ __forceinline__ void pk4_frag(const f32x16& P, bf16x8& out) {
    const unsigned a0 = cvt_pk_bf16(P[BASE + 0], P[BASE + 1]), a1 = cvt_pk_bf16(P[BASE + 2], P[BASE + 3]), b0 = cvt_pk_bf16(P[BASE + 4], P[BASE + 5]), b1 = cvt_pk_bf16(P[BASE + 6], P[BASE + 7]);
    auto r0 = __builtin_amdgcn_permlane32_swap(a0, b0, false, false); auto r1 = __builtin_amdgcn_permlane32_swap(a1, b1, false, false);
    u32x4 w = {r0[0], r1[0], r0[1], r1[1]}; out = *reinterpret_cast<bf16x8*>(&w);
}
template <int D0> __device__ __forceinline__ void pv_both(f32x16& oa, f32x16& ob, int vb, const bf16x8 (&pa)[4], const bf16x8 (&pb)[4]) {
    const s16x4 l0 = tr_read<v_rd_off(D0, 0, 0)>(vb), h0 = tr_read<v_rd_off(D0, 0, 1)>(vb), l1 = tr_read<v_rd_off(D0, 1, 0)>(vb), h1 = tr_read<v_rd_off(D0, 1, 1)>(vb);
    const s16x4 l2 = tr_read<v_rd_off(D0, 2, 0)>(vb), h2 = tr_read<v_rd_off(D0, 2, 1)>(vb), l3 = tr_read<v_rd_off(D0, 3, 0)>(vb), h3 = tr_read<v_rd_off(D0, 3, 1)>(vb);
    asm volatile("s_waitcnt lgkmcnt(0)" ::: "memory"); SBAR();
#define PK(L, H) (bf16x8){L[0], L[1], L[2], L[3], H[0], H[1], H[2], H[3]}
    const bf16x8 v0 = PK(l0, h0), v1 = PK(l1, h1), v2 = PK(l2, h2), v3 = PK(l3, h3);
    oa = __builtin_amdgcn_mfma_f32_32x32x16_bf16(pa[0], v0, oa, 0, 0, 0);
    ob = __builtin_amdgcn_mfma_f32_32x32x16_bf16(pb[0], v0, ob, 0, 0, 0);
    oa = __builtin_amdgcn_mfma_f32_32x32x16_bf16(pa[1], v1, oa, 0, 0, 0);
    ob = __builtin_amdgcn_mfma_f32_32x32x16_bf16(pb[1], v1, ob, 0, 0, 0);
    oa = __builtin_amdgcn_mfma_f32_32x32x16_bf16(pa[2], v2, oa, 0, 0, 0);
    ob = __builtin_amdgcn_mfma_f32_32x32x16_bf16(pb[2], v2, ob, 0, 0, 0);
    oa = __builtin_amdgcn_mfma_f32_32x32x16_bf16(pa[3], v3, oa, 0, 0, 0);
    ob = __builtin_amdgcn_mfma_f32_32x32x16_bf16(pb[3], v3, ob, 0, 0, 0);
#undef PK
}
template <int VAR>
__device__ __forceinline__ void attn_unit(const bf16_t* __restrict__ Qb, const bf16_t* __restrict__ Kh, const bf16_t* __restrict__ Vh, bf16_t* __restrict__ Ob,
                                          int nkeys, float lam, const float* __restrict__ subw, char* lds, const int wid) {
    int lane = (int)__lane_id(); asm volatile("" : "+v"(lane));
    const int r32 = lane & 31, hi = lane >> 5;
    char* V_lds = lds; char* K_lds = lds + 2 * SHM_V;
    float* ws = (float*)(lds + LDS_MISC + 256) + wid * 128;
    float m0 = -1e30f, l0 = 0.f, m1 = -1e30f, l1 = 0.f;
    f32x16 oa[4] = {}, ob[4] = {};
    bf16x8* qs = (bf16x8*)(lds + 2 * SHM_V + 3 * SHM_K + wid * 8192) + lane;
    { const bf16_t* Qw = Qb + (size_t)(wid * QBLK + r32) * DM + hi * 8;
#pragma unroll
      for (int d0 = 0; d0 < 8; ++d0) qs[d0 * 64] = *reinterpret_cast<const bf16x8*>(Qw + d0 * 16); }
    const int vb0 = (int)(uintptr_t)V_lds + v_rd_base(lane);
    LAS unsigned char* ldsK = (LAS unsigned char*)K_lds + wid * 1024; LAS unsigned char* ldsV = (LAS unsigned char*)V_lds + wid * 1024;
    const __amdgpu_buffer_rsrc_t rsrcK = __builtin_amdgcn_make_buffer_rsrc((void*)Kh, 0, 0x7fffffff, 0x00020000), rsrcV = __builtin_amdgcn_make_buffer_rsrc((void*)Vh, 0, 0x7fffffff, 0x00020000);
    int goffK[2], goffV[2];
#pragma unroll
    for (int i = 0; i < 2; ++i) { const int p = wid + 8 * i;
        const int krow = 4 * p + (lane >> 4), kch = (lane & 15) ^ (krow & 15);
        goffK[i] = (krow * DM + kch * 8) * 2;
        const int within = lane & 31, kk = 8 * (p >> 1) + (within >> 2), k = (kk & ~0xC) | ((kk & 4) << 1) | ((kk & 8) >> 1), c = 32 * (2 * (p & 1) + (lane >> 5)) + 8 * (within & 3);
        goffV[i] = (k * DM + c) * 2; }
#define DMA_K(t, b) do { if constexpr ((VAR & 8) != 0) break; const int so_ = (t) * (KVBLK * DM * 2); \
    _Pragma("unroll") for (int _i = 0; _i < 2; ++_i) __builtin_amdgcn_raw_ptr_buffer_load_lds(rsrcK, (LAS void*)(ldsK + (b) * SHM_K + _i * 8192), 16, goffK[_i], so_, 0, 0); } while (0)
#define DMA_V(t, b) do { if constexpr ((VAR & 8) != 0) break; const int so_ = (t) * (KVBLK * DM * 2); \
    _Pragma("unroll") for (int _i = 0; _i < 2; ++_i) __builtin_amdgcn_raw_ptr_buffer_load_lds(rsrcV, (LAS void*)(ldsV + (b) * SHM_V + _i * 8192), 16, goffV[_i], so_, 0, 0); } while (0)
#define WAIT_BAR(N) do { if constexpr ((VAR & 16) != 0) { asm volatile("s_waitcnt vmcnt(" #N ") lgkmcnt(0)" ::: "memory"); } else { asm volatile("s_waitcnt vmcnt(" #N ") lgkmcnt(0)\n\ts_barrier" ::: "memory"); } } while (0)
#define RESC(o, a) do { if (__any((a) < 1.f)) { if (hi == 0) ws[r32] = (a); LDS_WAIT(); \
    _Pragma("unroll") for (int d = 0; d < 4; ++d) _Pragma("unroll") for (int r = 0; r < 16; ++r) o[d][r] *= ws[crow(r, hi)]; } } while (0)
    const int NT = nkeys / KVBLK;
    const int half = wid >> 2;
    DMA_K(0, 0); DMA_V(0, 0);
    WAIT_BAR(0);
#define QKT_V(p0, p1, Kt, q, mb) do { if constexpr ((VAR & 1) != 0) { _Pragma("unroll") for (int r_ = 0; r_ < 16; ++r_) { p0[r_] = 0.01f * (float)(r_ + r32); p1[r_] = 0.02f * (float)(r_ + hi); } } else qkt_map(p0, p1, Kt, q, mb, r32, hi); } while (0)
#define SM_V(p0, p1, m, l, al, f0, f1, f2, f3) do { if constexpr ((VAR & 2) != 0) { al = 1.f; pk4_frag<0>(p0, f0); pk4_frag<8>(p0, f1); pk4_frag<0>(p1, f2); pk4_frag<8>(p1, f3); l += p0[0]; } else softmax_tile(p0, p1, m, l, al, f0, f1, f2, f3); } while (0)
#define STEP_H1(b) do { const char* Kt = K_lds + (b) * SHM_K; f32x16 p0, p1, q0, q1; float al; \
        QKT_V(p0, p1, Kt, qs, 0); QKT_V(q0, q1, Kt, qs + 256, 128);          \
        SM_V(p0, p1, m0, l0, al, pa[0], pa[1], pa[2], pa[3]); RESC(oa, al); \
        SM_V(q0, q1, m1, l1, al, pb[0], pb[1], pb[2], pb[3]); RESC(ob, al); } while (0)
#define STEP_H2(b) do { const int vb = vb0 + (b) * (int)SHM_V; \
        if constexpr ((VAR & 4) != 0) { oa[0][0] += __builtin_bit_cast(float, (int)pa[0][0] + (int)pb[1][1] + vb); } else { \
        pv_both<0>(oa[0], ob[0], vb, pa, pb); pv_both<1>(oa[1], ob[1], vb, pa, pb); pv_both<2>(oa[2], ob[2], vb, pa, pb); pv_both<3>(oa[3], ob[3], vb, pa, pb); } } while (0)
#define STEP_X(kb) do { const char* Kt = K_lds + (kb) * SHM_K; f32x16 p0, p1; float al; \
        QKT_V(p0, p1, Kt, qs, 0); SM_V(p0, p1, m0, l0, al, pa[0], pa[1], pa[2], pa[3]); RESC(oa, al); } while (0)
#define STEP_Y(kb, b) do { const char* Kt = K_lds + (kb) * SHM_K; f32x16 p0, p1; float al; \
        QKT_V(p0, p1, Kt, qs + 256, 128); SM_V(p0, p1, m1, l1, al, pb[0], pb[1], pb[2], pb[3]); RESC(ob, al); STEP_H2(b); } while (0)
#ifndef ATT_STAGGER
#define ATT_STAGGER 0
#endif
    if (!ATT_STAGGER) {
        (void)half;
        for (int j = 0; j < NT; ++j) {
            const int b = j & 1; bf16x8 pa[4], pb[4];
            if (j + 1 < NT) { DMA_K(j + 1, b ^ 1); DMA_V(j + 1, b ^ 1); }
            STEP_H1(b);
            STEP_H2(b);
            WAIT_BAR(0);
        }
    } else if (half == 0) {
        int kb = 0;
        for (int j = 0; j < NT; ++j) {
            const int b = j & 1, kbn = kb == 2 ? 0 : kb + 1; bf16x8 pa[4], pb[4];
            const bool more = j + 1 < NT;
            if (more) DMA_K(j + 1, kbn);
            STEP_X(kb);
            if (more) WAIT_BAR(2); else WAIT_BAR(0);
            if (more) DMA_V(j + 1, b ^ 1);
            STEP_Y(kb, b);
            if (more) WAIT_BAR(2); else WAIT_BAR(0);
            kb = kbn;
        }
        WAIT_BAR(0);
    } else {
        if (NT > 1) { DMA_K(1, 1); WAIT_BAR(2); } else WAIT_BAR(0);
        int kb = 0;
        for (int j = 0; j < NT; ++j) {
            const int b = j & 1, kbn = kb == 2 ? 0 : kb + 1, kbnn = kbn == 2 ? 0 : kbn + 1; bf16x8 pa[4], pb[4];
            if (j + 1 < NT) DMA_V(j + 1, b ^ 1);
            STEP_X(kb);
            if (j + 1 < NT) WAIT_BAR(2); else WAIT_BAR(0);
            if (j + 2 < NT) DMA_K(j + 2, kbnn);
            STEP_Y(kb, b);
            if (j + 2 < NT) WAIT_BAR(2); else WAIT_BAR(0);
            kb = kbn;
        }
    }
#undef STEP_X
#undef STEP_Y
#undef STEP_H1
#undef STEP_H2
#undef QKT_V
#undef SM_V
    if (hi == 0) { ws[r32] = l0; ws[32 + r32] = l1; }
    int lane_e = lane; asm volatile("" : "+v"(lane_e));
    const int r32e = lane_e & 31, hie = lane_e >> 5;
    LDS_WAIT();
    float ss[16];
#pragma unroll
    for (int r = 0; r < 16; ++r) { const float ra = __builtin_amdgcn_rcpf(ws[crow(r, hi)]), rb = lam * __builtin_amdgcn_rcpf(ws[32 + crow(r, hi)]);
        float s = 0.f;
#pragma unroll
        for (int d = 0; d < 4; ++d) { const float v = oa[d][r] * ra - ob[d][r] * rb; oa[d][r] = v; s += v * v; }
        ss[r] = s; }
#pragma unroll
    for (int r = 0; r < 16; ++r) {
        ss[r] = rsqrtf(half32_sum(ss[r]) * (1.f / 128.f) + NORM_EPS) * (1.f - LAM_INIT0);
    }
    float wv[4];
#pragma unroll
    for (int d = 0; d < 4; ++d) wv[d] = subw[d * 32 + r32e];
    unsigned char* Ow = (unsigned char*)Ob + (size_t)(wid * QBLK) * DM;
#pragma unroll
    for (int r = 0; r < 16; ++r) { const int orow = crow(r, hie);
#pragma unroll
        for (int d = 0; d < 4; ++d) { const float v = oa[d][r] * ss[r] * wv[d] * pg8::AO_SCALE; Ow[(size_t)orow * DM + d * 32 + r32e] = (unsigned char)__builtin_amdgcn_cvt_pk_fp8_f32(v, v, 0, false); } }
    __syncthreads();
#undef DMA_K
#undef DMA_V
#undef WAIT_BAR
#undef RESC
}

struct SmState { float m, l, mn, al, a, b, c, d; unsigned negm; bool upd; };
template <int C> __device__ __forceinline__ float max8(const f32x16& P0, const f32x16& P1) {
    constexpr int B = (C & 1) * 8;
    if constexpr (C < 2) { float a = fmaxf(fmaxf(P0[B], P0[B + 1]), P0[B + 2]); a = fmaxf(fmaxf(a, P0[B + 3]), P0[B + 4]); a = fmaxf(fmaxf(a, P0[B + 5]), P0[B + 6]); return fmaxf(a, P0[B + 7]); }
    else { float a = fmaxf(fmaxf(P1[B], P1[B + 1]), P1[B + 2]); a = fmaxf(fmaxf(a, P1[B + 3]), P1[B + 4]); a = fmaxf(fmaxf(a, P1[B + 5]), P1[B + 6]); return fmaxf(a, P1[B + 7]); }
}
__device__ __forceinline__ float vadd(float a, float b) { float r = a + b; asm volatile("" : "+v"(r)); return r; }
template <int C> __device__ __forceinline__ float sum8(const f32x16& P0, const f32x16& P1) {
    constexpr int B = (C & 1) * 8;
    const f32x16& P = C < 2 ? P0 : P1;
    const float t0 = vadd(P[B], P[B + 1]), t1 = vadd(P[B + 2], P[B + 3]), t2 = vadd(P[B + 4], P[B + 5]), t3 = vadd(P[B + 6], P[B + 7]);
    const float u0 = vadd(t0, t1), u1 = vadd(t2, t3);
    return vadd(u0, u1);
}
template <int E, bool SUB> __device__ __forceinline__ void exp_at(f32x16& P0, f32x16& P1, float mn) {
    if constexpr (E < 16) { P0[E] = __builtin_amdgcn_exp2f(SUB ? P0[E] - mn : P0[E]); asm volatile("" : "+v"(P0[E])); }
    else if constexpr (E < 32) { P1[E - 16] = __builtin_amdgcn_exp2f(SUB ? P1[E - 16] - mn : P1[E - 16]); asm volatile("" : "+v"(P1[E - 16])); }
}
#ifndef ATT_SUMTHR
#define ATT_SUMTHR 1.8446744e19f
#endif
constexpr float SUMTHR = ATT_SUMTHR, SUMLOW = 5.4e-20f;
template <int G> __device__ __forceinline__ void sm1_chunk(f32x16& P0, f32x16& P1) { exp_at<2 * G, false>(P0, P1, 0.f); exp_at<2 * G + 1, false>(P0, P1, 0.f); }
template <int G> __device__ __forceinline__ void sm2_chunk(f32x16& P0, f32x16& P1, SmState& s, bf16x8 (&f)[4], f32x16 (&o)[4], float* ws) {
    if constexpr (G == 0) s.a = sum8<0>(P0, P1);
    else if constexpr (G == 1) s.b = sum8<1>(P0, P1);
    else if constexpr (G == 2) s.c = sum8<2>(P0, P1);
    else if constexpr (G == 3) {
        const float pl = vadd(vadd(s.a, s.b), vadd(s.c, sum8<3>(P0, P1)));
        const float lnl = vadd(s.l, pl);
        if (__builtin_expect(__builtin_amdgcn_ballot_w64(pl <= SUMTHR && lnl >= SUMLOW) == ~0ull, 1)) s.l = lnl;
        else {
            float ps, ln;
            { auto rr = __builtin_amdgcn_permlane32_swap(__float_as_uint(pl), __float_as_uint(pl), false, false); ps = __uint_as_float(rr[0]) + __uint_as_float(rr[1]); }
            { auto rr = __builtin_amdgcn_permlane32_swap(__float_as_uint(s.l), __float_as_uint(s.l), false, false); ln = (__uint_as_float(rr[0]) + __uint_as_float(rr[1])) + ps; }
            float em = fmaxf(max8<0>(P0, P1), max8<1>(P0, P1)); em = fmaxf(em, fmaxf(max8<2>(P0, P1), max8<3>(P0, P1)));
            { auto rr = __builtin_amdgcn_permlane32_swap(__float_as_uint(em), __float_as_uint(em), false, false); em = fmaxf(__uint_as_float(rr[0]), __uint_as_float(rr[1])); }
            const float pmax = __builtin_amdgcn_logf(fmaxf(em, 1e-37f));
            const float mnew = s.m + (ln < SUMLOW ? pmax : fmaxf(pmax, 0.f));
            const unsigned hp = cvt_pk_bf16(mnew, 0.f) & 0xffffu; const float mh = bflo(hp);
            const unsigned lp = cvt_pk_bf16(mnew - mh, 0.f) & 0xffffu; const float mt = mh + bflo(lp);
            const float al = __builtin_amdgcn_exp2f(s.m - mt); s.m = mt;
            const int ln_ = opaque_lane(), r32_ = ln_ & 31, hi_ = ln_ >> 5;
            s.negm = hi_ == 0 ? ((hp | (lp << 16)) ^ 0x80008000u) : 0u;
#pragma unroll
            for (int r = 0; r < 16; ++r) { P0[r] *= al; P1[r] *= al; }
            s.l = s.l * al + pl * al; s.upd = true;
            if (__any(al != 1.f)) { if (hi_ == 0) ws[r32_] = al; LDS_WAIT();
#pragma unroll
                for (int d = 0; d < 4; ++d)
#pragma unroll
                    for (int r = 0; r < 16; ++r) o[d][r] *= ws[crow(r, hi_)]; } } }
    else if constexpr (G == 4) pk4_frag<0>(P0, f[0]);
    else if constexpr (G == 5) pk4_frag<8>(P0, f[1]);
    else if constexpr (G == 6) pk4_frag<0>(P1, f[2]);
    else pk4_frag<8>(P1, f[3]);
}
#define MF32(A_, B_, C_) __builtin_amdgcn_mfma_f32_32x32x16_bf16(A_, B_, C_, 0, 0, 0)
__device__ __forceinline__ void attn_unit_pipe(const bf16_t* __restrict__ Qb, const bf16_t* __restrict__ Kh, const bf16_t* __restrict__ Vh, bf16_t* __restrict__ Ob,
                                               int nkeys, float lam, const float* __restrict__ subw, char* lds, const int wid) {
    const int lane = opaque_lane();
    const int r32 = lane & 31, hi = lane >> 5;
    char* V_lds = lds; char* K_lds = lds + 2 * SHM_V;
    float* ws = (float*)(lds + LDS_MISC + 256) + wid * 128;
    SmState st0, st1; st0.m = 0.f; st0.l = 0.f; st0.mn = 0.f; st0.al = 1.f; st0.negm = 0u; st0.upd = false; st0.a = st0.b = st0.c = st0.d = 0.f; st1 = st0;
    f32x16 oa[4] = {}, ob[4] = {};
    bf16x8* qs = (bf16x8*)(lds + 2 * SHM_V + 3 * SHM_K + wid * 8192) + lane;
    { const bf16_t* Qw = Qb + (size_t)(wid * QBLK + r32) * DM + hi * 8;
#pragma unroll
      for (int d0 = 0; d0 < 8; ++d0) qs[d0 * 64] = *reinterpret_cast<const bf16x8*>(Qw + d0 * 16); }
    const int vb0 = (int)(uintptr_t)V_lds + v_rd_base(lane);
    LAS unsigned char* ldsK = (LAS unsigned char*)K_lds + wid * 1024; LAS unsigned char* ldsV = (LAS unsigned char*)V_lds + wid * 1024;
    const __amdgpu_buffer_rsrc_t rsrcK = __builtin_amdgcn_make_buffer_rsrc((void*)Kh, 0, 0x7fffffff, 0x00020000), rsrcV = __builtin_amdgcn_make_buffer_rsrc((void*)Vh, 0, 0x7fffffff, 0x00020000);
    int goffK, goffV;
    { const int p = wid;
      const int krow = 4 * p + (lane >> 4), kch = (lane & 15) ^ (krow & 15);
      goffK = (krow * DM + kch * 8) * 2;
      const int within = lane & 31, kk = 8 * (p >> 1) + (within >> 2), k = (kk & ~0xC) | ((kk & 4) << 1) | ((kk & 8) >> 1), c = 32 * (2 * (p & 1) + (lane >> 5)) + 8 * (within & 3);
      goffV = (k * DM + c) * 2; }
#define PDMA_K(t, b) do { const int so_ = (t) * (KVBLK * DM * 2); \
    _Pragma("unroll") for (int _i = 0; _i < 2; ++_i) __builtin_amdgcn_raw_ptr_buffer_load_lds(rsrcK, (LAS void*)(ldsK + (b) * SHM_K + _i * 8192), 16, goffK, so_ + _i * (32 * DM * 2), 0, 0); } while (0)
#define PDMA_V(t, b) do { const int so_ = (t) * (KVBLK * DM * 2); \
    _Pragma("unroll") for (int _i = 0; _i < 2; ++_i) __builtin_amdgcn_raw_ptr_buffer_load_lds(rsrcV, (LAS void*)(ldsV + (b) * SHM_V + _i * 8192), 16, goffV, so_ + _i * (32 * DM * 2), 0, 0); } while (0)
#define PWAIT_BAR() asm volatile("s_waitcnt vmcnt(0) lgkmcnt(0)\n\ts_barrier" ::: "memory")
    const int z0 = ((int)(uintptr_t)K_lds + r32 * 256) ^ ((r32 & 15) << 4) ^ (hi << 4);
#define KL0(D0, Kt_, MB_) (*(const LAS bf16x8*)(uintptr_t)(unsigned)((Kt_) ^ ((MB_) + (D0) * 32)))
#define KL1(D0, Kt_, MB_) (*(const LAS bf16x8*)(uintptr_t)(unsigned)(((Kt_) ^ ((MB_) + (D0) * 32)) + 8192))
    bf16x8 kb0_, kb1_, kqa_, kqb_;
#define QK_SEG(P0, P1, Kt_, QS_, MB_, NEGM_, CH, REF_, PRE) do { const f32x16 z_ = {}; \
        if (!(PRE)) { kb0_ = KL0(0, Kt_, MB_); kqa_ = (QS_)[0]; kb1_ = KL1(0, Kt_, MB_); } SBAR(); \
        P0 = MF32(kb0_, kqa_, z_); kb0_ = KL0(1, Kt_, MB_); kqb_ = (QS_)[64];  CH(0); SBAR(); P1 = MF32(kb1_, kqa_, z_); kb1_ = KL1(1, Kt_, MB_); CH(1); SBAR(); \
        P0 = MF32(kb0_, kqb_, P0); kb0_ = KL0(2, Kt_, MB_); kqa_ = (QS_)[128]; CH(2); SBAR(); P1 = MF32(kb1_, kqb_, P1); kb1_ = KL1(2, Kt_, MB_); CH(3); SBAR(); \
        P0 = MF32(kb0_, kqa_, P0); kb0_ = KL0(3, Kt_, MB_); kqb_ = (QS_)[192]; CH(4); SBAR(); P1 = MF32(kb1_, kqa_, P1); kb1_ = KL1(3, Kt_, MB_); CH(5); SBAR(); \
        P0 = MF32(kb0_, kqb_, P0); CH(6); SBAR(); P1 = MF32(kb1_, kqb_, P1); CH(7); SBAR(); \
        if (REF_) { const bf16x8 on_ = __builtin_bit_cast(bf16x8, (u32x4){hi == 0 ? 0x3F803F80u : 0u, 0u, 0u, 0u}), ng_ = __builtin_bit_cast(bf16x8, (u32x4){(NEGM_), 0u, 0u, 0u}); \
          P0 = MF32(on_, ng_, P0); P1 = MF32(on_, ng_, P1); SBAR(); } } while (0)
#define VLD1(KS, D) do { vl_[D] = tr_read<v_rd_off(D, KS, 0)>(vb_); vh_[D] = tr_read<v_rd_off(D, KS, 1)>(vb_); } while (0)
#define PKV(D) (bf16x8){vl_[D][0], vl_[D][1], vl_[D][2], vl_[D][3], vh_[D][0], vh_[D][1], vh_[D][2], vh_[D][3]}
#define LGKM(N) asm volatile("s_waitcnt lgkmcnt(" #N ")" ::: "memory")
#define PV_ONE(o, f_, N, WN, CH) do { LGKM(WN); SBAR(); o[(N) & 3] = MF32(f_, PKV((N) & 3), o[(N) & 3]); if ((N) + 3 < 16) VLD1(((N) + 3) >> 2, ((N) + 3) & 3); CH(N); SBAR(); } while (0)
#define PV_SEG(o, pf, vbase, CH) do { const int vb_ = (vbase); s16x4 vl_[4], vh_[4]; \
        VLD1(0, 0); VLD1(0, 1); VLD1(0, 2); \
        PV_ONE(o, pf[0], 0, 4, CH);  PV_ONE(o, pf[0], 1, 4, CH);  PV_ONE(o, pf[0], 2, 4, CH);  PV_ONE(o, pf[0], 3, 4, CH); \
        PV_ONE(o, pf[1], 4, 4, CH);  PV_ONE(o, pf[1], 5, 4, CH);  PV_ONE(o, pf[1], 6, 4, CH);  PV_ONE(o, pf[1], 7, 4, CH); \
        PV_ONE(o, pf[2], 8, 4, CH);  PV_ONE(o, pf[2], 9, 4, CH);  PV_ONE(o, pf[2], 10, 4, CH); PV_ONE(o, pf[2], 11, 4, CH); \
        PV_ONE(o, pf[3], 12, 4, CH); PV_ONE(o, pf[3], 13, 4, CH); PV_ONE(o, pf[3], 14, 2, CH); PV_ONE(o, pf[3], 15, 0, CH); } while (0)
#define PV_ONEK(o, f_, N, WN, CH, LD_) do { LGKM(WN); SBAR(); o[(N) & 3] = MF32(f_, PKV((N) & 3), o[(N) & 3]); if ((N) + 3 < 16) VLD1(((N) + 3) >> 2, ((N) + 3) & 3); LD_; CH(N); SBAR(); } while (0)
#define PV_SEGK(o, pf, vbase, CH, Kt_, QS_, MB_) do { const int vb_ = (vbase); s16x4 vl_[4], vh_[4]; \
        VLD1(0, 0); VLD1(0, 1); VLD1(0, 2); \
        PV_ONE(o, pf[0], 0, 4, CH);  PV_ONE(o, pf[0], 1, 4, CH);  PV_ONE(o, pf[0], 2, 4, CH);  PV_ONE(o, pf[0], 3, 4, CH); \
        PV_ONE(o, pf[1], 4, 4, CH);  PV_ONE(o, pf[1], 5, 4, CH);  PV_ONE(o, pf[1], 6, 4, CH);  PV_ONE(o, pf[1], 7, 4, CH); \
        PV_ONE(o, pf[2], 8, 4, CH);  PV_ONE(o, pf[2], 9, 4, CH);  PV_ONE(o, pf[2], 10, 4, CH); PV_ONE(o, pf[2], 11, 4, CH); \
        PV_ONEK(o, pf[3], 12, 4, CH, kb0_ = KL0(0, Kt_, MB_)); PV_ONEK(o, pf[3], 13, 5, CH, kqa_ = (QS_)[0]); PV_ONEK(o, pf[3], 14, 4, CH, kb1_ = KL1(0, Kt_, MB_)); PV_ONEK(o, pf[3], 15, 3, CH, (void)0); } while (0)
#define CH_NONE(k) do {} while (0)
#define CH_P2_0(k) sm2_chunk<k>(p0, p1, st0, pa, oa, ws)
#define CH_P1_1(k) sm1_chunk<k>(q0, q1)
#define CH_P2_1(k) sm2_chunk<k>(q0, q1, st1, pb, ob, ws)
#define CH_P1_0(k) sm1_chunk<k>(p0, p1)
#define RUN16(CH) do { CH(0); CH(1); CH(2); CH(3); CH(4); CH(5); CH(6); CH(7); CH(8); CH(9); CH(10); CH(11); CH(12); CH(13); CH(14); CH(15); } while (0)
#define RUN8(CH) do { CH(0); SBAR(); CH(1); SBAR(); CH(2); SBAR(); CH(3); SBAR(); CH(4); SBAR(); CH(5); SBAR(); CH(6); SBAR(); CH(7); SBAR(); } while (0)
    const int NT = nkeys / KVBLK;
    PDMA_K(0, 0); PDMA_V(0, 0); if (NT > 1) PDMA_K(1, 1);
    PWAIT_BAR();
    f32x16 p0, p1, q0, q1; bf16x8 pa[4], pb[4];
    QK_SEG(p0, p1, z0, qs, 0, 0u, CH_NONE, false, false);
    RUN16(CH_P1_0);
    int kb = 0;
    if (wid >= 4) __builtin_amdgcn_s_setprio(1);
    asm volatile(".p2align 8\n\t.fill 0, 4, 0xBF800000" ::: "memory");
    for (int j = 0; j + 1 < NT; ++j) {
        const int vbb = j & 1, kb1 = kb == 2 ? 0 : kb + 1, kb2 = kb1 == 2 ? 0 : kb1 + 1;
        if (j + 2 < NT) PDMA_K(j + 2, kb2);
        PDMA_V(j + 1, vbb ^ 1);
        const int vb = vb0 + vbb * (int)SHM_V;
        QK_SEG(q0, q1, z0 + kb * (int)SHM_K, qs + 256, 128, st1.negm, CH_P2_0, st1.upd, j > 0);
        PV_SEGK(oa, pa, vb, CH_P1_1, z0 + kb1 * (int)SHM_K, qs, 0);
        QK_SEG(p0, p1, z0 + kb1 * (int)SHM_K, qs, 0, st0.negm, CH_P2_1, st0.upd, true);
        PV_SEGK(ob, pb, vb, CH_P1_0, z0 + kb1 * (int)SHM_K, qs + 256, 128);
        PWAIT_BAR();
        kb = kb1;
    }
    { const int vb = vb0 + ((NT - 1) & 1) * (int)SHM_V;
      QK_SEG(q0, q1, z0 + kb * (int)SHM_K, qs + 256, 128, st1.negm, CH_P2_0, st1.upd, NT > 1);
      PV_SEG(oa, pa, vb, CH_P1_1);
      RUN8(CH_P2_1);
      PV_SEG(ob, pb, vb, CH_NONE); }
    __builtin_amdgcn_s_setprio(0);
    float l0, l1;
    { auto r0 = __builtin_amdgcn_permlane32_swap(__float_as_uint(st0.l), __float_as_uint(st0.l), false, false); l0 = __uint_as_float(r0[0]) + __uint_as_float(r0[1]);
      auto r1 = __builtin_amdgcn_permlane32_swap(__float_as_uint(st1.l), __float_as_uint(st1.l), false, false); l1 = __uint_as_float(r1[0]) + __uint_as_float(r1[1]); }
    const int lane_e = opaque_lane(), r32e = lane_e & 31, hie = lane_e >> 5;
    if (hie == 0) { ws[r32e] = l0; ws[32 + r32e] = l1; }
    LDS_WAIT();
    float ss[16];
#pragma unroll
    for (int r = 0; r < 16; ++r) { const float ra = __builtin_amdgcn_rcpf(ws[crow(r, hie)]), rb = lam * __builtin_amdgcn_rcpf(ws[32 + crow(r, hie)]);
        float sq = 0.f;
#pragma unroll
        for (int d = 0; d < 4; ++d) { const float v = oa[d][r] * ra - ob[d][r] * rb; oa[d][r] = v; sq += v * v; }
        ss[r] = sq; }
#pragma unroll
    for (int r = 0; r < 16; ++r) {
        ss[r] = rsqrtf(half32_sum(ss[r]) * (1.f / 128.f) + NORM_EPS) * (1.f - LAM_INIT0);
    }
    float wv[4];
#pragma unroll
    for (int d = 0; d < 4; ++d) wv[d] = subw[d * 32 + r32e];
    unsigned char* Ow = (unsigned char*)Ob + (size_t)(wid * QBLK) * DM;
#pragma unroll
    for (int r = 0; r < 16; ++r) { const int orow = crow(r, hie);
#pragma unroll
        for (int d = 0; d < 4; ++d) { const float v = oa[d][r] * ss[r] * wv[d] * pg8::AO_SCALE; Ow[(size_t)orow * DM + d * 32 + r32e] = (unsigned char)__builtin_amdgcn_cvt_pk_fp8_f32(v, v, 0, false); } }
    __syncthreads();
#undef PDMA_K
#undef PDMA_V
#undef PWAIT_BAR
#undef KL0
#undef KL1
#undef QK_SEG
#undef VLD1
#undef PKV
#undef LGKM
#undef PV_ONE
#undef PV_ONEK
#undef PV_SEGK
#undef PV_SEG
#undef CH_NONE
#undef CH_P2_0
#undef CH_P1_1
#undef CH_P2_1
#undef CH_P1_0
#undef RUN16
#undef RUN8
}
#undef MF32
}

#ifndef ATT_PIPE
#define ATT_PIPE 1
#endif
#if ATT_PIPE
#define ATT_UNIT att::attn_unit_pipe
#else
#define ATT_UNIT att::attn_unit<0>
#endif
struct Args { const float* in[23]; float* out; unsigned char* ws; int ph_lo, ph_hi; };


__device__ __forceinline__ int map_qkv(int n0) {
    if (n0 >= 2048) return n0;
    const int sec = n0 >> 10, nn = n0 & 1023, blk = nn >> 6, half = (nn >> 5) & 1;
    return sec * 1024 + 256 * (blk >> 2) + 128 * half + 32 * (blk & 3);
}
__device__ __forceinline__ int map_gu(int n0) {
    const int half = n0 >> 10, nn = n0 & 1023;
    return 256 * (nn >> 7) + 128 * half + (nn & 127);
}

#ifndef PH_MASK
#define PH_MASK 0xFFFFFu
#endif
#define IN(k) (((PH_MASK >> (k)) & 1u) && lo <= (k) && (k) < hi_ph)
#ifndef MK_STAMP
#define MK_STAMP 0
#endif
#ifndef MK_STAMP_A
#define MK_STAMP_A 3
#endif
#ifndef MK_STAMP_B
#define MK_STAMP_B 0
#endif
#if MK_STAMP
#define STAMP(k) do { if (blockIdx.x == 0 && tid == 0) ((unsigned long long*)(ws + 40960))[(k)] = wall_clock64(); } while (0)
#else
#define STAMP(k) do {} while (0)
#endif
#define SEAM(k) do { if (IN(k) && IN((k) + 1)) xcd_barrier(bar, wave == 0 && opaque_lane() == 0); STAMP((k) + 1); } while (0)
#define MOD ((float*)(ws + WS_MOD))
#define ROPE ((float*)(ws + WS_ROPE))
#define HIST ((int*)(ws + WS_HIST))
#define BLKEXP ((int*)(ws + WS_BLKEXP))
#define WGT ((float*)(ws + WS_WGT))
#define TOKE ((int*)(ws + WS_TOKE))
#define TOKG ((float*)(ws + WS_TOKG))
#define TOKR ((int*)(ws + WS_TOKR))
#define ROWTOK ((unsigned*)(ws + WS_ROWTOK))
#define GZ ((float*)(ws + WS_GZ))
#define DEC ((float*)(ws + WS_DEC))
#define WQKV ((bf16_t*)(ws + WS_WQKV))
#define WO ((bf16_t*)(ws + WS_WO))
#define WGIN ((bf16_t*)(ws + WS_WGIN))
#define WGOUT ((bf16_t*)(ws + WS_WGOUT))
#define WGU ((unsigned char*)(ws + WS_WGU))
#define WD ((unsigned char*)(ws + WS_WD))
#define TB ((bf16_t*)(ws + WS_T))
#define QB ((bf16_t*)(ws + WS_Q))
#define KC ((bf16_t*)(ws + WS_KC))
#define VC ((bf16_t*)(ws + WS_VC))
#define AO ((bf16_t*)(ws + WS_AO))
#define YB ((bf16_t*)(ws + WS_Y))
#define UB ((unsigned char*)(ws + WS_U))
#define X1 ((bf16_t*)(ws + WS_X1))
#define X2 ((bf16_t*)(ws + WS_X2))
#define XS ((unsigned char*)(ws + WS_XS))
#define XSB16 ((bf16_t*)(ws + WS_XS))
#define HB ((unsigned char*)(ws + WS_H))
#define YD XS
#define GQ QB
#define GK (QB + (size_t)T0 * 512)
#define GV KC
#define GR VC
#define DS ((bf16_t*)(ws + WS_H))


template <int L>
__device__ __forceinline__ void moe_layer(unsigned char* ws, unsigned char* lds, const XcdBarrier& bar, const int lo, const int hi_ph, const int wave, const int pvar) {
    const int lane = (int)__lane_id(), tid = wave * 64 + lane;
    const int G = gridDim.x, blk = blockIdx.x;
    constexpr int NT = L == 0 ? T0 : TLAT;
    constexpr int pb = L == 0 ? 5 : 15;
    const float* modl = MOD + (size_t)L * 5 * 6144;
    const int per = NT / G;
    if (IN(pb)) {
        const int lane = opaque_lane(), tid = wave * 64 + lane; (void)tid; (void)lane;
        bf16_t* UH = (bf16_t*)lds;
        bf16_t* UL = (bf16_t*)(lds + 33024);
        float* PART = (float*)(lds + 66560);
        int* HL = (int*)(lds + 98304);
        const float* lng = INP(I_LNG) + (size_t)(L * 2 + 0) * DM; const float* lnb = INP(I_LNB) + (size_t)(L * 2 + 0) * DM;
        const float* rw = INP(I_RW) + (size_t)L * DM * NEXP; const float* rb = INP(I_RB) + L * NEXP;
        const int e = lane & 31, hh = lane >> 5;
        bf16x8 wh[4][2], wl[4][2];
#pragma unroll
        for (int ks = 0; ks < 4; ++ks)
#pragma unroll
            for (int cb = 0; cb < 2; ++cb) { unsigned hw[4], lw[4];
#pragma unroll
                for (int jp = 0; jp < 4; ++jp) { const int k = 128 * wave + 32 * ks + 8 * (lane >> 4) + 2 * jp;
                    const float w0 = rw[(size_t)k * NEXP + 16 * cb + (lane & 15)], w1 = rw[(size_t)(k + 1) * NEXP + 16 * cb + (lane & 15)];
                    const unsigned hp = cvt_pk_bf16(w0, w1); hw[jp] = hp; lw[jp] = cvt_pk_bf16(w0 - bflo(hp), w1 - bfhi(hp)); }
                wh[ks][cb] = __builtin_bit_cast(bf16x8, (u32x4){hw[0], hw[1], hw[2], hw[3]}); wl[ks][cb] = __builtin_bit_cast(bf16x8, (u32x4){lw[0], lw[1], lw[2], lw[3]}); }
        const int t0 = blk * per;
        const int mrow0 = t0 < TLAT ? (t0 >> 13) : 4, mrow1 = (t0 + per - 1) < TLAT ? ((t0 + per - 1) >> 13) : 4;
        float* AM = (float*)(lds + 100352);
        float* ALN = AM + 2 * 3 * 1024;
        for (int i = tid; i < 2 * 3 * 1024; i += 512) { const int st = i / 3072, v = (i >> 10) % 3, c = i & 1023; AM[i] = modl[(size_t)(st ? mrow1 : mrow0) * 6144 + 2048 + v * 1024 + c]; }
        for (int i = tid; i < 2048; i += 512) ALN[i] = i < 1024 ? lng[i] : lnb[i - 1024];
        if (tid < 32) HL[tid] = 0;
        __syncthreads();
        f32x4 xa[4], xb[4]; u32x2 ya[4], yb[4];
#define ROW_PTRS(bt_, q_, xin_, yin_, ok_) const int rr_ = 2 * wave + (q_), r_ = t0 + (bt_) + rr_; const bool ok_ = (bt_) + rr_ < per && (bt_) < per; \
        const void* xin_ = L == 0 ? (const void*)(r_ < TLAT ? INP(I_X) + (size_t)r_ * DM : INP(I_CTX) + (size_t)(r_ - TLAT) * DM) : (const void*)(X2 + (size_t)r_ * DM); const bf16_t* yin_ = YB + (size_t)r_ * DM
#define ROW_LOAD(bt_, q_, xn, yn) do { ROW_PTRS(bt_, q_, xp, yp, okp); \
          if (okp) { _Pragma("unroll") for (int j = 0; j < 4; ++j) { xn[j] = L == 0 ? *(const f32x4*)((const float*)xp + 4 * lane + 256 * j) : bf4_f32(*(const u32x2*)((const bf16_t*)xp + 4 * lane + 256 * j)); yn[j] = *(const u32x2*)(yp + 4 * lane + 256 * j); } } } while (0)
        ROW_LOAD(0, 0, xa, ya); ROW_LOAD(0, 1, xb, yb);
        for (int bt = 0; bt < per; bt += 16) {
            auto do_row = [&](const int q, f32x4 (&xn)[4], u32x2 (&yn)[4]) __attribute__((always_inline)) { const int rr = 2 * wave + q, r = t0 + bt + rr;
                f32x4 xc[4]; u32x2 yc[4];
#pragma unroll
                for (int j = 0; j < 4; ++j) { xc[j] = xn[j]; yc[j] = yn[j]; }
                ROW_LOAD(bt + 16, q, xn, yn);
                if (bt + rr < per && !(pvar & 2)) {
                    const int mrow = r < TLAT ? (r >> 13) : 4;
                    const float* mod = AM + (mrow != mrow0 ? 3072 : 0);
                    f32x4 v[4]; float s = 0.f;
#pragma unroll
                    for (int j = 0; j < 4; ++j) { const int idx = 4 * lane + 256 * j; const f32x4 xv = xc[j], g1 = *(const f32x4*)(mod + idx);
                        const u32x2 yy = yc[j];
                        v[j][0] = ALPHA * xv[0] + g1[0] * bflo(yy.x); v[j][1] = ALPHA * xv[1] + g1[1] * bfhi(yy.x); v[j][2] = ALPHA * xv[2] + g1[2] * bflo(yy.y); v[j][3] = ALPHA * xv[3] + g1[3] * bfhi(yy.y);
                        s += (v[j][0] + v[j][1]) + (v[j][2] + v[j][3]); }
                    const float mean = wave_sum(s) * (1.f / DM); float s2 = 0.f;
#pragma unroll
                    for (int j = 0; j < 4; ++j) { v[j] = v[j] - mean; s2 += (v[j][0] * v[j][0] + v[j][1] * v[j][1]) + (v[j][2] * v[j][2] + v[j][3] * v[j][3]); }
                    const float rstd = rsqrtf(wave_sum(s2) * (1.f / DM) + NORM_EPS);
#pragma unroll
                    for (int j = 0; j < 4; ++j) { const int idx = 4 * lane + 256 * j; const f32x4 gg = *(const f32x4*)(ALN + idx), bb = *(const f32x4*)(ALN + 1024 + idx);
                        const f32x4 sh = *(const f32x4*)(mod + 1024 + idx), sc = *(const f32x4*)(mod + 2048 + idx);
                        f32x4 x1 = v[j] * rstd * gg + bb;
                        { u32x2 o1; o1.x = cvt_pk_bf16(x1[0], x1[1]); o1.y = cvt_pk_bf16(x1[2], x1[3]); *(u32x2*)(X1 + (size_t)r * DM + idx) = o1; }
                        f32x4 u = x1 * (1.f + sc) + sh;
                        { u32x2 uh, ul; uh.x = cvt_pk_bf16(u[0], u[1]); uh.y = cvt_pk_bf16(u[2], u[3]);
                          ul.x = cvt_pk_bf16(u[0] - bflo(uh.x), u[1] - bfhi(uh.x)); ul.y = cvt_pk_bf16(u[2] - bflo(uh.y), u[3] - bfhi(uh.y));
                          *(u32x2*)(UH + rr * 1032 + idx) = uh; *(u32x2*)(UL + rr * 1032 + idx) = ul; }
                        *(unsigned*)(UB + (size_t)r * DM + idx) = pg8::pk4_fp8(u[0], u[1], u[2], u[3]); }
                }
            };
            do_row(0, xa, ya); do_row(1, xb, yb);
            __syncthreads();
            if (!(pvar & 1)) {
            { f32x4 lacc[2] = {{0.f, 0.f, 0.f, 0.f}, {0.f, 0.f, 0.f, 0.f}};
#pragma unroll
              for (int ks = 0; ks < 4; ++ks) { const int ko = (lane & 15) * 1032 + 128 * wave + 32 * ks + 8 * (lane >> 4);
                  const bf16x8 ah = *(const bf16x8*)(UH + ko), al = *(const bf16x8*)(UL + ko);
#pragma unroll
                  for (int cb = 0; cb < 2; ++cb) {
                      lacc[cb] = __builtin_amdgcn_mfma_f32_16x16x32_bf16(ah, wh[ks][cb], lacc[cb], 0, 0, 0);
                      lacc[cb] = __builtin_amdgcn_mfma_f32_16x16x32_bf16(al, wh[ks][cb], lacc[cb], 0, 0, 0);
                      lacc[cb] = __builtin_amdgcn_mfma_f32_16x16x32_bf16(ah, wl[ks][cb], lacc[cb], 0, 0, 0); } }
#pragma unroll
              for (int cb = 0; cb < 2; ++cb)
#pragma unroll
                  for (int i = 0; i < 4; ++i) PART[(wave * 16 + 4 * (lane >> 4) + i) * 32 + 16 * cb + (lane & 15)] = lacc[cb][i]; }
            __syncthreads();
            { const int rr = 2 * wave + hh, r = t0 + bt + rr;
              float lg = rb[e];
#pragma unroll
              for (int w = 0; w < 8; ++w) lg += PART[(w * 16 + rr) * 32 + e];
              float tv[4]; int ti[4];
#pragma unroll
              for (int t = 0; t < 4; ++t) { const float mx = half_max(lg, hh);
                  int cand = half_min((lg == mx) ? e : 99, hh);
                  cand = cand > 31 ? t : cand;
                  tv[t] = mx; ti[t] = cand; if (e == cand) lg = -__builtin_inff(); }
              if (bt + rr < per && e == 0) {
                  const float e1 = __expf(tv[1] - tv[0]), e2 = __expf(tv[2] - tv[0]), e3 = __expf(tv[3] - tv[0]); const float inv = 1.f / (1.f + e1 + e2 + e3);
                  *(f32x4*)(TOKG + (size_t)r * 4) = (f32x4){inv, e1 * inv, e2 * inv, e3 * inv};
                  int* te = TOKE + (size_t)r * 4; te[0] = ti[0]; te[1] = ti[1]; te[2] = ti[2]; te[3] = ti[3];
                  atomicAdd(&HL[ti[0]], 1); atomicAdd(&HL[ti[1]], 1); atomicAdd(&HL[ti[2]], 1); atomicAdd(&HL[ti[3]], 1); } }
            }
            __syncthreads();
        }
        if (tid < 32) HIST[blk * 32 + tid] = HL[tid];
    }
    SEAM(pb);

    if (IN(pb + 1)) {
        const int lane = opaque_lane(), tid = wave * 64 + lane; (void)tid; (void)lane;
        int* SA = (int*)lds; int* SB_ = SA + 512; int* PS = SB_ + 512; int* BASE = PS + 64; int* EL = BASE + 32; int* RL = EL + 1024;
        { const int e = tid & 31, part = tid >> 5; int sa = 0, sb = 0;
#pragma unroll 8
          for (int bb = part; bb < G; bb += 16) { const int hv = HIST[bb * 32 + e]; sa += hv; if (bb < blk) sb += hv; }
          SA[part * 32 + e] = sa; SB_[part * 32 + e] = sb; }
        __syncthreads();
        if (tid < 32) { int tot = 0, bef = 0;
            for (int p = 0; p < 16; ++p) { tot += SA[p * 32 + tid]; bef += SB_[p * 32 + tid]; }
            const int padded = (tot + 255) & ~255;
            int incl = padded;
#pragma unroll
            for (int o = 1; o < 32; o <<= 1) { const int t = __shfl_up(incl, o); if (tid >= o) incl += t; }
            const int pstart = incl - padded;
            PS[tid] = pstart; BASE[tid] = pstart + bef; PS[32 + tid] = pstart + tot;
            if (blk == 0) {
                for (int rbk = pstart >> 8; rbk < (incl >> 8); ++rbk) BLKEXP[rbk] = tid; BLKEXP[600 + tid] = pstart >> 8; BLKEXP[640 + tid] = padded >> 8; if (tid == 31) BLKEXP[1023] = incl >> 8; } }
        const int t0 = blk * per, na = per * 4;
        for (int i = tid; i < na; i += 512) EL[i] = TOKE[(size_t)t0 * 4 + i];
        __syncthreads();
        if (blk == 0) { const int e = tid >> 4, j = tid & 15; const int end = (PS[32 + e] + 255) & ~255;
            for (int rr = PS[32 + e] + j; rr < end; rr += 16) ROWTOK[rr] = 0u; }
        { int* CNT = RL + 1024;
          const int nch = (na + 63) >> 6;
          int myr[2] = {0, 0}, mye[2] = {-1, -1};
#pragma unroll
          for (int k = 0; k < 2; ++k) { const int c = wave + 8 * k;
              if (c < nch) { const int i = c * 64 + lane; const int ei = i < na ? EL[i] : -1; int r_ = 0, cn_ = 0;
                  for (int e = 0; e < 32; ++e) { const unsigned long long m = __ballot(ei == e);
                      const int below = (int)__builtin_amdgcn_mbcnt_hi((unsigned)(m >> 32), __builtin_amdgcn_mbcnt_lo((unsigned)m, 0u));
                      if (ei == e) r_ = below; if (lane == e) cn_ = __popcll(m); }
                  if (lane < 32) CNT[c * 32 + lane] = cn_;
                  myr[k] = r_; mye[k] = ei; } }
          __syncthreads();
#pragma unroll
          for (int k = 0; k < 2; ++k) { const int c = wave + 8 * k;
              if (c < nch && mye[k] >= 0) { int base = BASE[mye[k]]; for (int cc = 0; cc < c; ++cc) base += CNT[cc * 32 + mye[k]];
                  RL[c * 64 + lane] = base + myr[k]; } } }
        __syncthreads();
        for (int i = tid; i < na; i += 512) TOKR[(size_t)t0 * 4 + i] = RL[i];
        for (int i = tid; i < na; i += 512) ROWTOK[RL[i]] = (unsigned)(t0 + (i >> 2)) * (unsigned)DM;
    }
    SEAM(pb + 1);

    if (IN(pb + 2)) {
        const int lane = opaque_lane(), tid = wave * 64 + lane; (void)tid; (void)lane;
        const int nblk = __builtin_amdgcn_readfirstlane(BLKEXP[1023]);
        pg8::MoeOrder S; S.init(UB, WGU + (size_t)L * 32 * 2048 * 1024, BLKEXP, nblk, 8, G, blk, 1);
        pg8::EpiGateUp E{ws, lds, L};
        pg8::gemm_phase<pg8::EpiGateUp, pg8::MoeOrder, true, true, 1, true>((LAS unsigned char*)lds, S, E, wave, ROWTOK);
    }
    SEAM(pb + 2);

    if (IN(pb + 3)) {
        const int lane = opaque_lane(), tid = wave * 64 + lane; (void)tid; (void)lane;
        const int nblk = __builtin_amdgcn_readfirstlane(BLKEXP[1023]);
        pg8::MoeOrder S; S.init(HB, WD + (size_t)L * 32 * 1024 * 1024, BLKEXP, nblk, 4, G, blk, 1);
        pg8::EpiDown E{ws, lds, L};
        pg8::gemm_phase<pg8::EpiDown, pg8::MoeOrder, true, true, 1>((LAS unsigned char*)lds, S, E, wave);
    }
    SEAM(pb + 3);

    if (IN(pb + 4)) {
        const int lane = opaque_lane(), tid = wave * 64 + lane; (void)tid; (void)lane;
        const float* lng = INP(I_LNG) + (size_t)(L * 2 + 1) * DM; const float* lnb = INP(I_LNB) + (size_t)(L * 2 + 1) * DM;
        constexpr int NV = L == 0 ? 3 : 1;
        float* EM = (float*)lds;
        float* ELN = EM + 5 * NV * 1024;
        for (int i = tid; i < 5 * NV * 1024; i += 512) { const int mr = i / (NV * 1024), v = (i >> 10) % NV, c = i & 1023;
            EM[i] = v == 0 ? modl[(size_t)mr * 6144 + 5120 + c] : MOD[(size_t)(5 + mr) * 6144 + (v - 1) * 1024 + c]; }
        for (int i = tid; i < 2048; i += 512) ELN[i] = i < 1024 ? lng[i] : lnb[i - 1024];
        __syncthreads();
        const int rstep = G * 8;
        f32x4 gt_n, gt_nn; int rw_n[4], rw_nn[4]; unsigned yn[4][4]; u32x2 xn[4];
#define LD_IDX(r_, g_, w_) do { if ((r_) < NT) { g_ = *(const f32x4*)(TOKG + (size_t)(r_) * 4); const int* tr_ = TOKR + (size_t)(r_) * 4; w_[0] = tr_[0]; w_[1] = tr_[1]; w_[2] = tr_[2]; w_[3] = tr_[3]; } } while (0)
#define LD_DATA(r_, w_) do { if ((r_) < NT) { _Pragma("unroll") for (int j = 0; j < 4; ++j) { const int idx = 4 * lane + 256 * j; \
            _Pragma("unroll") for (int k = 0; k < 4; ++k) yn[k][j] = *(const unsigned*)(YD + (size_t)w_[k] * DM + idx); \
            xn[j] = *(const u32x2*)(X1 + (size_t)(r_) * DM + idx); } } } while (0)
        { const int r0 = blk * 8 + wave; LD_IDX(r0, gt_n, rw_n); LD_DATA(r0, rw_n); LD_IDX(r0 + rstep, gt_nn, rw_nn); }
        for (int r = blk * 8 + wave; r < NT; r += rstep) {
            const int mrow = r < TLAT ? (r >> 13) : 4;
            const float* mod = EM + mrow * (NV * 1024);
            const f32x4 gt = gt_n;
            unsigned yc[4][4]; u32x2 xc[4];
#pragma unroll
            for (int j = 0; j < 4; ++j) { xc[j] = xn[j];
#pragma unroll
                for (int k = 0; k < 4; ++k) yc[k][j] = yn[k][j]; }
            gt_n = gt_nn;
#pragma unroll
            for (int k = 0; k < 4; ++k) rw_n[k] = rw_nn[k];
            LD_DATA(r + rstep, rw_n);
            LD_IDX(r + 2 * rstep, gt_nn, rw_nn);
            f32x4 v[4]; float s = 0.f;
#pragma unroll
            for (int j = 0; j < 4; ++j) { const int idx = 4 * lane + 256 * j;
                const f32x4 xv = bf4_f32(xc[j]), g2 = *(const f32x4*)(mod + idx);
                f32x4 f = {0.f, 0.f, 0.f, 0.f};
#pragma unroll
                for (int k = 0; k < 4; ++k) { const f32x2 lo = __builtin_amdgcn_cvt_pk_f32_fp8((int)yc[k][j], false), hi = __builtin_amdgcn_cvt_pk_f32_fp8((int)yc[k][j], true);
                    const float gk = gt[k] * (1.f / pg8::Y_SCALE);
                    f[0] += gk * lo[0]; f[1] += gk * lo[1]; f[2] += gk * hi[0]; f[3] += gk * hi[1]; }
                v[j] = ALPHA * xv + g2 * f;
                s += (v[j][0] + v[j][1]) + (v[j][2] + v[j][3]); }
            const float mean = wave_sum(s) * (1.f / DM); float s2 = 0.f;
#pragma unroll
            for (int j = 0; j < 4; ++j) { v[j] = v[j] - mean; s2 += (v[j][0] * v[j][0] + v[j][1] * v[j][1]) + (v[j][2] * v[j][2] + v[j][3] * v[j][3]); }
            const float rstd = rsqrtf(wave_sum(s2) * (1.f / DM) + NORM_EPS);
#pragma unroll
            for (int j = 0; j < 4; ++j) { const int idx = 4 * lane + 256 * j; const f32x4 gg = *(const f32x4*)(ELN + idx), bb = *(const f32x4*)(ELN + 1024 + idx);
                const f32x4 x2 = v[j] * rstd * gg + bb;
                if (L == 0) {
                    { u32x2 o2; o2.x = cvt_pk_bf16(x2[0], x2[1]); o2.y = cvt_pk_bf16(x2[2], x2[3]); *(u32x2*)(X2 + (size_t)r * DM + idx) = o2; }
                    const f32x4 sh = *(const f32x4*)(mod + 1024 + idx), sc = *(const f32x4*)(mod + 2048 + idx);
                    const f32x4 t = x2 * (1.f + sc) + sh;
                    *(unsigned*)((unsigned char*)TB + (size_t)r * DM + idx) = pg8::pk4_fp8(t[0], t[1], t[2], t[3]);
                } else *(f32x4*)((float*)INP(23) + (size_t)r * DM + idx) = x2; }
        }
#undef LD_IDX
#undef LD_DATA
    }
    if (L == 0) SEAM(pb + 4);
}

template <int MAP>
__device__ __forceinline__ void transpose_item_fp8(const float* __restrict__ W, int N, unsigned char* __restrict__ WT, int k0, int n0, float scale, char* scr, int lane) {
    const int kr = lane >> 3, nc = (lane & 7) * 4;
    f32x4 v[16];
    const float* src = W + (size_t)(k0 + 16 * kr) * N + n0 + nc;
#pragma unroll
    for (int i = 0; i < 16; ++i) v[i] = *(const f32x4*)(src + (size_t)i * N) * scale;
#pragma unroll
    for (int jn = 0; jn < 4; ++jn) {
        u32x4 c0;
        c0.x = pg8::pk4_fp8(v[0][jn], v[1][jn], v[2][jn], v[3][jn]); c0.y = pg8::pk4_fp8(v[4][jn], v[5][jn], v[6][jn], v[7][jn]);
        c0.z = pg8::pk4_fp8(v[8][jn], v[9][jn], v[10][jn], v[11][jn]); c0.w = pg8::pk4_fp8(v[12][jn], v[13][jn], v[14][jn], v[15][jn]);
        *(u32x4*)(scr + (nc + jn) * 144 + kr * 16) = c0;
    }
    LDS_WAIT(); asm volatile("" ::: "memory");
    const int c = lane & 7;
    const int drow0 = MAP == 2 ? map_gu(n0) : MAP == 1 ? map_qkv(n0) : n0;
#pragma unroll
    for (int j = 0; j < 4; ++j) { const int n = (lane >> 3) + 8 * j;
        const u32x4 o = *(const u32x4*)(scr + n * 144 + 16 * c);
        *(u32x4*)(WT + (size_t)(drow0 + n) * 1024 + k0 + 16 * c) = o; }
    LDS_WAIT(); asm volatile("" ::: "memory");
}

template <int MAP>
__device__ __forceinline__ void transpose_item64(const float* __restrict__ W, int N, bf16_t* __restrict__ WT, int k0, int n0, char* scr, int lane) {
    const int kr = lane >> 4, nc = (lane & 15) * 4;
    const bool ok = n0 + nc < N;
    f32x4 v[16];
    const float* src = W + (size_t)(k0 + 16 * kr) * N + n0 + nc;
#pragma unroll
    for (int i = 0; i < 16; ++i) v[i] = ok ? *(const f32x4*)(src + (size_t)i * N) : (f32x4){0.f, 0.f, 0.f, 0.f};
#pragma unroll
    for (int jn = 0; jn < 4; ++jn) {
        u32x4 c0, c1;
        c0.x = cvt_pk_bf16(v[0][jn], v[1][jn]); c0.y = cvt_pk_bf16(v[2][jn], v[3][jn]); c0.z = cvt_pk_bf16(v[4][jn], v[5][jn]); c0.w = cvt_pk_bf16(v[6][jn], v[7][jn]);
        c1.x = cvt_pk_bf16(v[8][jn], v[9][jn]); c1.y = cvt_pk_bf16(v[10][jn], v[11][jn]); c1.z = cvt_pk_bf16(v[12][jn], v[13][jn]); c1.w = cvt_pk_bf16(v[14][jn], v[15][jn]);
        *(u32x4*)(scr + (nc + jn) * 144 + kr * 32) = c0; *(u32x4*)(scr + (nc + jn) * 144 + kr * 32 + 16) = c1;
    }
    LDS_WAIT(); asm volatile("" ::: "memory");
    const int c = lane & 7;
#pragma unroll
    for (int j = 0; j < 8; ++j) { const int n = (lane >> 3) + 8 * j;
        const u32x4 o = *(const u32x4*)(scr + n * 144 + 16 * c);
        const int ng = n0 + (n & 32);
        const int drow = (MAP == 1 ? map_qkv(ng) : MAP == 2 ? map_gu(ng) : ng) + (n & 31);
        if (n0 + n < N) *(u32x4*)(WT + (size_t)drow * 1024 + k0 + 8 * c) = o; }
    LDS_WAIT(); asm volatile("" ::: "memory");
}

__global__ void __launch_bounds__(512, 2) fwd_kernel(Args args) {
    extern __shared__ __attribute__((aligned(16))) unsigned char lds[];
    const int wave = __builtin_amdgcn_readfirstlane((int)threadIdx.x >> 6), lane = opaque_lane(), tid = wave * 64 + lane;
    const int G = gridDim.x, blk = blockIdx.x;
    unsigned char* ws = args.ws;
    const int lo = args.ph_lo & 0xFF, hi_ph = args.ph_hi, pvar = args.ph_lo >> 8;

    volatile LAS unsigned* misc = (volatile LAS unsigned*)((LAS unsigned char*)lds + LDS_MISC);
    if (tid < 4) misc[tid] = 0u;
    if (tid < 24) { const unsigned long long p = tid < 23 ? (unsigned long long)args.in[tid] : (unsigned long long)args.out; *(unsigned long long*)(lds + LDS_MISC + 64 + 8 * tid) = p; }
    __syncthreads();
    XcdBarrier bar; bar.bar = (unsigned*)(ws + WS_CTL); bar.x = 0; bar.st = misc;
    if (hi_ph - lo > 1) bar = xcd_barrier_post((unsigned*)(ws + WS_CTL), misc, wave == 0 && opaque_lane() == 0);
    STAMP(0);


    if (IN(0)) {
        const int lane = opaque_lane(), tid = wave * 64 + lane; (void)tid; (void)lane;
        float* S = (float*)lds;
        float* PART = (float*)lds + 5 * 1024;
        for (int i = tid; i < 5 * 1024; i += 512) { const int r = i >> 10, k = i & 1023; const float v = r < 4 ? INP(I_C)[r * 1024 + k] : INP(I_CCTX)[k]; S[i] = siluf(v); }
        __syncthreads();
        for (int item = blk; item < 256; item += G) {
            const int l = item >> 7, n = (item & 127) * 48 + (lane < 48 ? lane : 47);
            const float* wp = INP(I_ADAW) + (size_t)l * 1024 * 6144 + n;
            float a0 = 0.f, a1 = 0.f, a2 = 0.f, a3 = 0.f, a4 = 0.f;
#pragma unroll 8
            for (int kk = 0; kk < 128; ++kk) { const int k = wave * 128 + kk; const float w = wp[(size_t)k * 6144];
                a0 += S[k] * w; a1 += S[1024 + k] * w; a2 += S[2048 + k] * w; a3 += S[3072 + k] * w; a4 += S[4096 + k] * w; }
            float* pp = PART + wave * 320 + lane;
            pp[0] = a0; pp[64] = a1; pp[128] = a2; pp[192] = a3; pp[256] = a4;
            __syncthreads();
            if (tid < 320) { const int r = tid >> 6, ln = tid & 63; float s = 0.f;
#pragma unroll
                for (int w = 0; w < 8; ++w) s += PART[w * 320 + r * 64 + ln];
                const int nn = (item & 127) * 48 + ln;
                if (ln < 48) MOD[((size_t)l * 5 + r) * 6144 + nn] = s + INP(I_ADAB)[l * 6144 + nn]; }
            __syncthreads();
        }
        if (blk == G - 1) for (int i = tid; i < 2048; i += 512) { const int v = i >> 4, jj = i & 15; const float inv = powf(10000.f, -(float)jj / 16.f); const float ang = (float)v * inv;
            ROPE[2 * i] = cosf(ang); ROPE[2 * i + 1] = sinf(ang); }
        for (int i = blk * 512 + tid; i < 2 * 512 * 16; i += G * 512) { const int r = i & 15, col = (i >> 4) & 511, dir = i >> 13; WGT[i] = INP(I_GWGATE)[(size_t)(dir * 16 + r) * 512 + col]; }
        for (int i = blk * 512 + tid; i < (GIN_NP - GIN_N) * 1024 / 16; i += G * 512) ((u32x4*)((unsigned char*)WGIN + (size_t)GIN_N * 1024))[i] = (u32x4){0u, 0u, 0u, 0u};
        __syncthreads();
        char* scr = (char*)lds + wave * 9216;
        const int gw = blk * 8 + wave, NGW = G * 8;
        constexpr int I_A = 16 * 48, I_B = 16 * 16, I_C2 = 16 * 49, I_D = 16 * 16, I_SMALL = I_A + I_B + I_C2 + I_D, I_GUx = 64 * 16 * 32, I_DNx = 64 * 16 * 16;
        for (int it = gw; it < I_SMALL + I_GUx + I_DNx; it += NGW) {
            int r = it;
            if (r < I_A) { const int kb = r / 96, nb = r % 96; transpose_item_fp8<1>(INP(I_DAWIN), 3072, (unsigned char*)WQKV, 128 * kb, 32 * nb, pg8::QKV_SCALE, scr, lane); continue; } r -= I_A;
            if (r < I_B) { const int kb = r >> 5, nb = r & 31; transpose_item_fp8<0>(INP(I_DAWOUT), 1024, (unsigned char*)WO, 128 * kb, 32 * nb, pg8::WO_SCALE, scr, lane); continue; } r -= I_B;
            if (r < I_C2) { if (r < 8 * 97) { const int kb = r / 97, nb = r % 97; transpose_item_fp8<0>(INP(I_GWIN), GIN_N, (unsigned char*)WGIN, 128 * kb, 32 * nb, pg8::GIN_SCALE, scr, lane); } continue; } r -= I_C2;
            if (r < I_D) { const int kb = r >> 4, nb = r & 15; transpose_item64<0>(INP(I_GWOUT), 1024, WGOUT, 64 * kb, 64 * nb, scr, lane); continue; } r -= I_D;
            if (r < I_GUx) { const int mat = r >> 9, q = r & 511, kb = q >> 6, nb = q & 63;
                transpose_item_fp8<2>(INP(I_WGU) + (size_t)mat * 1024 * 2048, 2048, WGU + (size_t)mat * 2048 * 1024, 128 * kb, 32 * nb, pg8::WGU_SCALE, scr, lane); continue; } r -= I_GUx;
            { const int mat = r >> 8, q = r & 255, kb = q >> 5, nb = q & 31;
                transpose_item_fp8<0>(INP(I_WD) + (size_t)mat * 1024 * 1024, 1024, WD + (size_t)mat * 1024 * 1024, 128 * kb, 32 * nb, pg8::WD_SCALE, scr, lane); }
        }
    }
    SEAM(0);

    if (IN(1)) {
        const int lane = opaque_lane(), tid = wave * 64 + lane; (void)tid; (void)lane;
        float* PM = (float*)lds;
        for (int i = tid; i < 5 * 2048; i += 512) PM[i] = MOD[(size_t)(i >> 11) * 6144 + (i & 2047)];
        __syncthreads();
        for (int r = blk * 8 + wave; r < T0; r += G * 8) {
            const float* src = r < TLAT ? INP(I_X) + (size_t)r * DM : INP(I_CTX) + (size_t)(r - TLAT) * DM;
            const float* mod = PM + (r < TLAT ? (r >> 13) : 4) * 2048;
#pragma unroll
            for (int j = 0; j < 4; ++j) { const int idx = 4 * lane + 256 * j;
                const f32x4 v = *(const f32x4*)(src + idx), sh = *(const f32x4*)(mod + idx), sc = *(const f32x4*)(mod + 1024 + idx);
                *(unsigned*)((unsigned char*)TB + (size_t)r * DM + idx) = pg8::pk4_fp8(v[0] * (1.f + sc[0]) + sh[0], v[1] * (1.f + sc[1]) + sh[1], v[2] * (1.f + sc[2]) + sh[2], v[3] * (1.f + sc[3]) + sh[3]); }
        }
    }
    SEAM(1);

    if (IN(2)) {
        const int lane = opaque_lane(), tid = wave * 64 + lane; (void)tid; (void)lane;
        pg8::DenseOrder S; S.init(TB, WQKV, T0, 3072, G, blk, 1);
        pg8::EpiQKV E{QB, KC, VC, ROPE};
        pg8::gemm_phase<pg8::EpiQKV, pg8::DenseOrder, true, true, 1>((LAS unsigned char*)lds, S, E, wave);
    }
    SEAM(2);

    if (IN(3)) {
        const int lane = opaque_lane(), tid = wave * 64 + lane; (void)tid; (void)lane;
        const float* lv = INP(I_DALAM);
        const float s1 = wave_sum(lv[lane] * lv[64 + lane]), s2 = wave_sum(lv[128 + lane] * lv[192 + lane]);
        const float lam = __builtin_bit_cast(float, __builtin_amdgcn_readfirstlane(__builtin_bit_cast(int, expf(s1) - expf(s2) + LAM_INIT0)));
        for (int i = 0;; ++i) {
            const int L = i * G + blk;
            if (L >= 1024 + 32) break;
            if (L < 1024) {
                int bh, qb;
                if (G == 256) { bh = i * 8 + (blk & 7); qb = blk >> 3; }
                else { bh = L >> 5; qb = L & 31; }
                const int b = bh >> 3, h = bh & 7;
                ATT_UNIT(QB + ((size_t)b * SEQ + qb * 256) * DM + h * 128, KC + (size_t)b * KVLEN * DM + h * 128, VC + (size_t)b * KVLEN * DM + h * 128,
                               (bf16_t*)((unsigned char*)AO + ((size_t)b * SEQ + qb * 256) * DM + h * 128), KVLEN, lam, INP(I_DASUBLN), (char*)lds, wave);
            } else {
                const int bh = L - 1024, b = bh >> 3, h = bh & 7;
                ATT_UNIT(QB + ((size_t)TLAT + b * NCTX) * DM + h * 128, KC + (size_t)b * KVLEN * DM + h * 128, VC + (size_t)b * KVLEN * DM + h * 128,
                               (bf16_t*)((unsigned char*)AO + ((size_t)TLAT + b * NCTX) * DM + h * 128), NCTX, lam, INP(I_DASUBLN), (char*)lds, wave);
            }
        }
    }
    SEAM(3);

    if (IN(4)) {
        const int lane = opaque_lane(), tid = wave * 64 + lane; (void)tid; (void)lane;
        pg8::DenseOrder S; S.init(AO, WO, T0, 1024, G, blk, 1);
        pg8::EpiPlain E{YB, 1.f / (pg8::AO_SCALE * pg8::WO_SCALE)};
        pg8::gemm_phase<pg8::EpiPlain, pg8::DenseOrder, true, true, 1>((LAS unsigned char*)lds, S, E, wave);
    }
    SEAM(4);

    moe_layer<0>(ws, lds, bar, lo, hi_ph, wave, pvar);

    {
    if (IN(10)) {
        const int lane = opaque_lane(), tid = wave * 64 + lane; (void)tid; (void)lane;
        pg8::DenseOrder S; S.init(TB, WGIN, T0, GIN_NP, G, blk, 1);
        pg8::EpiGlaIn E{GQ, GK, GV, GR, GZ};
        pg8::gemm_phase<pg8::EpiGlaIn, pg8::DenseOrder, true, true, 1>((LAS unsigned char*)lds, S, E, wave);
    }
    SEAM(10);

    char* VL = (char*)lds;
    float* ZL = (float*)(lds + 32768);
    float* TOT = (float*)(lds + 40960);
    bf16_t* QL = (bf16_t*)(lds + 45056);
    bf16_t* KL = (bf16_t*)(lds + 63488);
    bf16_t* QI1 = (bf16_t*)(lds + 81920);
    bf16_t* KI1 = (bf16_t*)(lds + 100352);
    bf16_t* ATT = (bf16_t*)(lds + 118784);
    float* OL = (float*)lds;
    const float* bgt = INP(I_GBGATE);
#define GLA_STAGE(rowb_, withq_) do { const int sr_ = tid >> 4, sc_ = (tid & 15) * 8; \
        _Pragma("unroll") for (int th_ = 0; th_ < 2; ++th_) _Pragma("unroll") for (int hf_ = 0; hf_ < 2; ++hf_) \
            *(bf16x8*)(VL + th_ * 16384 + att::v_st(sr_ + 32 * hf_, sc_)) = *(const bf16x8*)(GV + ((rowb_) + sr_ + 32 * hf_) * 1024 + h * 256 + th_ * 128 + sc_); \
        _Pragma("unroll") for (int hf_ = 0; hf_ < 2; ++hf_) { *(bf16x8*)(KL + (sr_ + 32 * hf_) * 136 + sc_) = *(const bf16x8*)(GK + ((rowb_) + sr_ + 32 * hf_) * 512 + h * 128 + sc_); \
            if (withq_) *(bf16x8*)(QL + (sr_ + 32 * hf_) * 136 + sc_) = *(const bf16x8*)(GQ + ((rowb_) + sr_ + 32 * hf_) * 512 + h * 128 + sc_); } \
        *(f32x4*)(ZL + 4 * tid) = *(const f32x4*)(GZ + (rowb_) * 32 + 4 * tid); } while (0)
#define GLA_GATES_LOCAL(dir_, g) do { const int d_ = tid & 127, cg_ = tid >> 7; \
        { float wv_[16]; const f32x4* wp_ = (const f32x4*)(WGT + (size_t)((dir_) * 512 + h * 128 + d_) * 16); \
          _Pragma("unroll") for (int r_ = 0; r_ < 4; ++r_) { const f32x4 t_ = wp_[r_]; wv_[4 * r_] = t_[0]; wv_[4 * r_ + 1] = t_[1]; wv_[4 * r_ + 2] = t_[2]; wv_[4 * r_ + 3] = t_[3]; } \
          const float bias_ = bgt[(dir_) * 512 + h * 128 + d_]; \
          _Pragma("unroll") for (int i_ = 0; i_ < 16; ++i_) { const float* z_ = ZL + (16 * cg_ + i_) * 32 + (dir_) * 16; float xg_ = bias_; \
              _Pragma("unroll") for (int r_ = 0; r_ < 16; ++r_) xg_ += z_[r_] * wv_[r_]; \
              g[i_] = logsigf(xg_) * (1.f / 16.f); } } \
        if ((dir_) == 0) { _Pragma("unroll") for (int i_ = 1; i_ < 16; ++i_) g[i_] += g[i_ - 1]; TOT[(dir_) * 512 + cg_ * 128 + d_] = g[15]; } \
        else { _Pragma("unroll") for (int i_ = 14; i_ >= 0; --i_) g[i_] += g[i_ + 1]; TOT[(dir_) * 512 + cg_ * 128 + d_] = g[0]; } } while (0)
#define GLA_GATES_FIX(dir_, g, ball_) do { const int d_ = tid & 127, cg_ = tid >> 7; float pre_ = 0.f; ball_ = 0.f; \
        _Pragma("unroll") for (int q_ = 0; q_ < 4; ++q_) { const float t_ = TOT[(dir_) * 512 + q_ * 128 + d_]; ball_ += t_; if ((dir_) == 0 ? (q_ < cg_) : (q_ > cg_)) pre_ += t_; } \
        _Pragma("unroll") for (int i_ = 0; i_ < 16; ++i_) g[i_] += pre_; } while (0)
#define GLA_VFRAGS(vf) do { const s16x4 l0_ = att::tr_read<att::v_rd_off(0, 0, 0)>(vrdw), h0_ = att::tr_read<att::v_rd_off(0, 0, 1)>(vrdw), l1_ = att::tr_read<att::v_rd_off(0, 1, 0)>(vrdw), h1_ = att::tr_read<att::v_rd_off(0, 1, 1)>(vrdw); \
        const s16x4 l2_ = att::tr_read<att::v_rd_off(0, 2, 0)>(vrdw), h2_ = att::tr_read<att::v_rd_off(0, 2, 1)>(vrdw), l3_ = att::tr_read<att::v_rd_off(0, 3, 0)>(vrdw), h3_ = att::tr_read<att::v_rd_off(0, 3, 1)>(vrdw); \
        LDS_WAIT(); SBAR(); \
        vf[0] = (bf16x8){l0_[0], l0_[1], l0_[2], l0_[3], h0_[0], h0_[1], h0_[2], h0_[3]}; vf[1] = (bf16x8){l1_[0], l1_[1], l1_[2], l1_[3], h1_[0], h1_[1], h1_[2], h1_[3]}; \
        vf[2] = (bf16x8){l2_[0], l2_[1], l2_[2], l2_[3], h2_[0], h2_[1], h2_[2], h2_[3]}; vf[3] = (bf16x8){l3_[0], l3_[1], l3_[2], l3_[3], h3_[0], h3_[1], h3_[2], h3_[3]}; } while (0)
#define GLA_LANE() const int r32 = lane & 31, hi = lane >> 5; (void)r32; (void)hi; \
        const int vrdw = (int)(uintptr_t)VL + (wave >> 2) * 16384 + att::v_rd_base(lane) + (wave & 3) * 512

    if (IN(11)) {
        const int lane = opaque_lane(), tid = wave * 64 + lane; (void)tid; (void)lane;
        GLA_LANE();
        for (int it = blk; it < 16 * NPC; it += G) {
            const int bh = it / NPC, pc = it % NPC, b = bh >> 2, h = bh & 3;
            const size_t rowb = pc < 4 ? (size_t)TLAT + b * NCTX + 64 * pc : (size_t)b * SEQ + 64 * (pc - 4);
            GLA_STAGE(rowb, false);
            float g0[16], g1[16];
            __syncthreads();
            GLA_GATES_LOCAL(0, g0); GLA_GATES_LOCAL(1, g1);
            bf16x8 vf[4];
            GLA_VFRAGS(vf);
            __syncthreads();
            { const int d = tid & 127, cg = tid >> 7; float ball0, ball1;
              GLA_GATES_FIX(0, g0, ball0); GLA_GATES_FIX(1, g1, ball1);
              unsigned w0[8], w1[8];
#pragma unroll
              for (int p = 0; p < 8; ++p) { const int c = 16 * cg + 2 * p; const float ka = bf2f(KL[c * 136 + d]), kb = bf2f(KL[(c + 1) * 136 + d]);
                  w0[p] = cvt_pk_bf16(ka * __expf(ball0 - g0[2 * p]), kb * __expf(ball0 - g0[2 * p + 1]));
                  w1[p] = cvt_pk_bf16(ka * __expf(ball1 - g1[2 * p]), kb * __expf(ball1 - g1[2 * p + 1])); }
              *(u32x4*)(QL + d * 72 + 16 * cg) = (u32x4){w0[0], w0[1], w0[2], w0[3]}; *(u32x4*)(QL + d * 72 + 16 * cg + 8) = (u32x4){w0[4], w0[5], w0[6], w0[7]};
              *(u32x4*)(QI1 + d * 72 + 16 * cg) = (u32x4){w1[0], w1[1], w1[2], w1[3]}; *(u32x4*)(QI1 + d * 72 + 16 * cg + 8) = (u32x4){w1[4], w1[5], w1[6], w1[7]};
              if (cg == 0) { DEC[((size_t)(bh * 2) * NPC + pc) * 128 + d] = __expf(ball0); DEC[((size_t)(bh * 2 + 1) * NPC + pc) * 128 + d] = __expf(ball1); } }
            __syncthreads();
#pragma unroll
            for (int dir = 0; dir < 2; ++dir) {
                const bf16_t* KST = dir == 0 ? QL : QI1;
                f32x16 acc[4] = {};
#pragma unroll
                for (int ks = 0; ks < 4; ++ks)
#pragma unroll
                    for (int nb = 0; nb < 4; ++nb) { const bf16x8 a = *(const bf16x8*)(KST + (32 * nb + r32) * 72 + 16 * ks + 8 * hi);
                        acc[nb] = __builtin_amdgcn_mfma_f32_32x32x16_bf16(a, vf[ks], acc[nb], 0, 0, 0); }
                bf16_t* dsp = DS + ((size_t)(bh * 2 + dir) * NPC + pc) * 32768 + (size_t)wave * 4096 + lane * 8;
#pragma unroll
                for (int nb = 0; nb < 4; ++nb) { bf16x8 f0, f1; att::pk4_frag<0>(acc[nb], f0); att::pk4_frag<8>(acc[nb], f1);
                    *(bf16x8*)(dsp + (2 * nb) * 512) = f0; *(bf16x8*)(dsp + (2 * nb + 1) * 512) = f1; }
            }
            __syncthreads();
        }
    }
    SEAM(11);

    if (IN(12)) {
        const int lane = opaque_lane(), tid = wave * 64 + lane; (void)tid; (void)lane;
        for (int gid = blk * 512 + tid; gid < 32 * 4096; gid += G * 512) {
            const int seq = gid >> 12, f = gid & 4095, dir = seq & 1;
            const int d0 = 16 * ((f >> 6) & 7) + 8 * ((f >> 5) & 1);
            bf16_t* base = DS + (size_t)seq * NPC * 32768 + f * 8;
            const float* dbase = DEC + (size_t)seq * NPC * 128 + d0;
            float s[8];
#pragma unroll
            for (int i = 0; i < 8; ++i) s[i] = 0.f;
            for (int st0 = 0; st0 < NPC; st0 += 4) {
                u32x4 dv[4]; f32x4 da[4], db[4]; int pcs[4];
#pragma unroll
                for (int u = 0; u < 4; ++u) { const int st = st0 + u; const int pc = dir == 0 ? st : (st < 4 ? 3 - st : 135 - st); pcs[u] = pc;
                    dv[u] = *(const u32x4*)(base + (size_t)pc * 32768); da[u] = *(const f32x4*)(dbase + pc * 128); db[u] = *(const f32x4*)(dbase + pc * 128 + 4); }
#pragma unroll
                for (int u = 0; u < 4; ++u) {
                    if (pcs[u] >= 4) { u32x4 o; o.x = cvt_pk_bf16(s[0], s[1]); o.y = cvt_pk_bf16(s[2], s[3]); o.z = cvt_pk_bf16(s[4], s[5]); o.w = cvt_pk_bf16(s[6], s[7]);
                        *(u32x4*)(base + (size_t)pcs[u] * 32768) = o; }
                    s[0] = da[u][0] * s[0] + bflo(dv[u].x); s[1] = da[u][1] * s[1] + bfhi(dv[u].x); s[2] = da[u][2] * s[2] + bflo(dv[u].y); s[3] = da[u][3] * s[3] + bfhi(dv[u].y);
                    s[4] = db[u][0] * s[4] + bflo(dv[u].z); s[5] = db[u][1] * s[5] + bfhi(dv[u].z); s[6] = db[u][2] * s[6] + bflo(dv[u].w); s[7] = db[u][3] * s[7] + bfhi(dv[u].w);
                }
            }
        }
    }
    SEAM(12);

    if (IN(13)) {
        const int lane = opaque_lane(), tid = wave * 64 + lane; (void)tid; (void)lane;
        GLA_LANE();
        for (int it = blk; it < 16 * 128; it += G) {
            const int bh = it >> 7, n = it & 127, pc = n + 4, b = bh >> 2;
            int h = bh & 3; unsigned rowb32 = (unsigned)(b * SEQ + 64 * n);
            asm volatile("" : "+v"(h), "+v"(rowb32));
            const size_t rowb = rowb32;
            GLA_STAGE(rowb, true);
            float g0[16], g1[16];
            __syncthreads();
            GLA_GATES_LOCAL(0, g0); GLA_GATES_LOCAL(1, g1);
            bf16x8 vf[4];
            GLA_VFRAGS(vf);
            __syncthreads();
            { const int d = tid & 127, cg = tid >> 7; float ball0, ball1;
              GLA_GATES_FIX(0, g0, ball0); GLA_GATES_FIX(1, g1, ball1); (void)ball0; (void)ball1;
#pragma unroll 4
              for (int i = 0; i < 16; ++i) { const int c = 16 * cg + i; const float qv = bf2f(QL[c * 136 + d]), kv = bf2f(KL[c * 136 + d]);
                  QL[c * 136 + d] = (bf16_t)(cvt_pk_bf16(qv * __expf(g0[i]), 0.f) & 0xffffu);  KL[c * 136 + d] = (bf16_t)(cvt_pk_bf16(kv * __expf(-g0[i]), 0.f) & 0xffffu);
                  QI1[c * 136 + d] = (bf16_t)(cvt_pk_bf16(qv * __expf(g1[i]), 0.f) & 0xffffu); KI1[c * 136 + d] = (bf16_t)(cvt_pk_bf16(kv * __expf(-g1[i]), 0.f) & 0xffffu); } }
            __syncthreads();
            { const int dir = wave >> 2, cb = (wave >> 1) & 1, sb = wave & 1;
              const bf16_t* QI = dir == 0 ? QL : QI1; const bf16_t* KI = dir == 0 ? KL : KI1; f32x16 a = {};
#pragma unroll
              for (int ks = 0; ks < 8; ++ks) { const bf16x8 qa = *(const bf16x8*)(QI + (32 * cb + r32) * 136 + 16 * ks + 8 * hi), kb = *(const bf16x8*)(KI + (32 * sb + r32) * 136 + 16 * ks + 8 * hi);
                  a = __builtin_amdgcn_mfma_f32_32x32x16_bf16(qa, kb, a, 0, 0, 0); }
              int ln2 = lane; asm volatile("" : "+v"(ln2));
              const int hi2 = ln2 >> 5, r322 = ln2 & 31;
#pragma unroll
              for (int r = 0; r < 16; ++r) { const int c = 32 * cb + crow(r, hi2), s2 = 32 * sb + r322; const bool keep = dir == 0 ? (s2 <= c) : (s2 >= c);
                  ATT[dir * 4608 + c * 72 + s2] = (bf16_t)(cvt_pk_bf16(keep ? a[r] : 0.f, 0.f) & 0xffffu); } }
            __syncthreads();
            f32x16 o[2] = {};
#pragma unroll
            for (int dir = 0; dir < 2; ++dir) {
                const bf16_t* QI = dir == 0 ? QL : QI1;
                const bf16_t* sg = DS + ((size_t)(bh * 2 + dir) * NPC + pc) * 32768 + (size_t)wave * 4096 + lane * 8;
                bf16x8 sfr[8];
#pragma unroll
                for (int ks = 0; ks < 8; ++ks) sfr[ks] = *(const bf16x8*)(sg + ks * 512);
#pragma unroll
                for (int cb = 0; cb < 2; ++cb) {
#pragma unroll
                    for (int ks = 0; ks < 4; ++ks) { const bf16x8 a = *(const bf16x8*)(ATT + dir * 4608 + (32 * cb + r32) * 72 + 16 * ks + 8 * hi);
                        o[cb] = __builtin_amdgcn_mfma_f32_32x32x16_bf16(a, vf[ks], o[cb], 0, 0, 0); }
#pragma unroll
                    for (int ks = 0; ks < 8; ++ks) { const bf16x8 a = *(const bf16x8*)(QI + (32 * cb + r32) * 136 + 16 * ks + 8 * hi);
                        o[cb] = __builtin_amdgcn_mfma_f32_32x32x16_bf16(a, sfr[ks], o[cb], 0, 0, 0); } }
            }
            __syncthreads();
#pragma unroll
            for (int cb = 0; cb < 2; ++cb)
#pragma unroll
                for (int r = 0; r < 16; ++r) OL[(32 * cb + crow(r, hi)) * 260 + 32 * wave + r32] = o[cb][r];
            __syncthreads();
            const f32x4 nw = *(const f32x4*)(INP(I_GNORM) + 4 * lane);
#pragma unroll 2
            for (int q = 0; q < 8; ++q) { const int c = 8 * wave + q;
                const f32x4 v = *(const f32x4*)(OL + c * 260 + 4 * lane);
                const float ssum = wave_sum(v[0] * v[0] + v[1] * v[1] + v[2] * v[2] + v[3] * v[3]);
                const float rstd = rsqrtf(ssum * (1.f / 256.f) + NORM_EPS);
                const u32x2 rr = *(const u32x2*)(GR + (rowb + c) * 1024 + h * 256 + 4 * lane);
                u32x2 ov; ov.x = cvt_pk_bf16(v[0] * rstd * nw[0] * siluf(bflo(rr.x)), v[1] * rstd * nw[1] * siluf(bfhi(rr.x)));
                ov.y = cvt_pk_bf16(v[2] * rstd * nw[2] * siluf(bflo(rr.y)), v[3] * rstd * nw[3] * siluf(bfhi(rr.y)));
                *(u32x2*)(AO + (rowb + c) * DM + h * 256 + 4 * lane) = ov; }
            __syncthreads();
        }
    }
#undef GLA_STAGE
#undef GLA_LANE
#undef GLA_GATES_LOCAL
#undef GLA_GATES_FIX
#undef GLA_VFRAGS
    SEAM(13);

    if (IN(14)) {
        const int lane = opaque_lane(), tid = wave * 64 + lane; (void)tid; (void)lane;
        pg8::DenseOrder S; S.init(AO, WGOUT, TLAT, 1024, G, blk);
        pg8::EpiPlain E{YB, 1.f};
        pg8::gemm_phase<pg8::EpiPlain, pg8::DenseOrder, true, true>((LAS unsigned char*)lds, S, E, wave);
    }
    SEAM(14);

    }

    moe_layer<1>(ws, lds, bar, lo, hi_ph, wave, pvar);

#if MK_PROBE_ATT >= 0
    if (lo == 20) {
        const float lam = 0.2f;
        for (int i = 0;; ++i) { const int L = i * G + blk; if (L >= 1024) break;
            const int bh = i * 8 + (blk & 7), qb = blk >> 3, b = bh >> 3, h = bh & 7;
            att::attn_unit<MK_PROBE_ATT>(QB + ((size_t)b * SEQ + qb * 256) * DM + h * 128, KC + (size_t)b * KVLEN * DM + h * 128, VC + (size_t)b * KVLEN * DM + h * 128,
                           XSB16 + ((size_t)b * SEQ + qb * 256) * DM + h * 128, KVLEN, lam, INP(I_DASUBLN), (char*)lds, wave); }
    }
#endif
#if MK_STAMP
    xcd_barrier(bar, tid == 0); STAMP(20); xcd_barrier(bar, tid == 0);
    { const unsigned long long* st = (const unsigned long long*)(ws + 40960);
      const float ta = (float)(st[MK_STAMP_A + 1] - st[MK_STAMP_A]) * 0.01f, tb = (float)(st[MK_STAMP_B + 1] - st[MK_STAMP_B]) * 0.01f;
      float* outp = (float*)INP(23);
      const size_t n1 = (size_t)(tb * 1e4f);
      for (size_t i = (size_t)blk * 512 + tid; i < n1 && i < (size_t)TLAT * DM - 1; i += (size_t)G * 512) outp[i] = 10.f;
      if (blk == 0 && tid == 0) outp[(size_t)TLAT * DM - 1] = 10.f * ta; }
#endif
#undef IN
#undef SEAM
}


#ifndef MK_DEBUG
#define MK_DEBUG 0
#endif
#ifndef MK_DEBUG_CNT
#define MK_DEBUG_CNT 0
#endif
#ifndef MK_DEBUG_SUB
#define MK_DEBUG_SUB 0
#endif
#ifndef MK_DEBUG_MUL
#define MK_DEBUG_MUL 1
#endif
#if MK_DEBUG
__global__ void dbg_check(const void* p, size_t n, int kind, float lim, unsigned code, unsigned* flag) {
    unsigned bad = 0; size_t minidx = 0xFFFFFFFFull, maxidx = 0;
    for (size_t i = (size_t)blockIdx.x * blockDim.x + threadIdx.x; i < n; i += (size_t)gridDim.x * blockDim.x) {
        if (kind == 0) { const float v = bf2f(((const bf16_t*)p)[i]); if (!(fabsf(v) <= lim)) { ++bad; if (i < minidx) minidx = i; if (i > maxidx) maxidx = i; } }
        else if (kind == 1) { const float v = ((const float*)p)[i]; if (!(fabsf(v) <= lim)) ++bad; }
        else { const int v = ((const int*)p)[i]; if (v < 0 || v > (int)lim) ++bad; }
    }
    if (code == 0u) return;
    if (bad) { atomicAdd(flag + 1, bad); atomicCAS(flag, 0u, code); atomicMin(flag + 2, (unsigned)minidx); atomicMax(flag + 3, (unsigned)maxidx); }
}
__global__ void dbg_report(float* out, size_t n, const unsigned* flag) {
    const unsigned f = *flag;
    if (f == 0u) return;
    const unsigned cnt = flag[1];
    float val = 100.f * (float)f;
#if MK_DEBUG_CNT == 1
    val = 100.f * (float)(32 - __clz(cnt));
#elif MK_DEBUG_CNT == 2
    val = 100.f * (float)(1 + (flag[2] / 32768u) % 132u);
#elif MK_DEBUG_CNT == 3
    val = 100.f * (float)(1 + (flag[2] / 32768u) / 132u);
#elif MK_DEBUG_CNT == 4
    val = 100.f * (float)(1 + (flag[3] / 32768u) % 132u);
#elif MK_DEBUG_CNT == 6
    val = 100.f * (float)(1 + ((flag[2] % 32768u) / 128u) % 64u) + 10000.f * (float)(((flag[2] % 32768u) / 128u) / 64u);
#elif MK_DEBUG_CNT == 7
    val = 100.f * (float)(1 + (flag[2] % 128u) % 64u) + 10000.f * (float)((flag[2] % 128u) / 64u);
#elif MK_DEBUG_CNT == 5
    val = 100.f * (float)(1 + (flag[3] / 32768u) / 132u);
#endif
    for (size_t i = (size_t)blockIdx.x * blockDim.x + threadIdx.x; i < n; i += (size_t)gridDim.x * blockDim.x) out[i] = val;
}
#endif

extern "C" void kernel_launch(void* const* d_in, const int* in_sizes, int n_in, void* d_out, int out_size, void* d_ws, size_t ws_size, hipStream_t stream) {
    static int grid = 0;
    if (grid == 0) {
        if (n_in != 23 || out_size != TLAT * DM || ws_size < WS_END) { fprintf(stderr, "kernel_launch: unexpected shapes (n_in %d, out %d, ws %zu, need %zu)\n", n_in, out_size, ws_size, (size_t)WS_END); grid = -1; return; }
        int dev = 0, cus = 0;
        if (hipGetDevice(&dev) != hipSuccess || hipDeviceGetAttribute(&cus, hipDeviceAttributeMultiprocessorCount, dev) != hipSuccess) { grid = -1; return; }
        if (hipFuncSetAttribute((const void*)fwd_kernel, hipFuncAttributeMaxDynamicSharedMemorySize, LDS_BYTES) != hipSuccess) { fprintf(stderr, "kernel_launch: hipFuncSetAttribute failed\n"); grid = -1; return; }
        int per_cu = 0;
        if (hipOccupancyMaxActiveBlocksPerMultiprocessor(&per_cu, (const void*)fwd_kernel, 512, LDS_BYTES) != hipSuccess || per_cu < 1) { fprintf(stderr, "kernel_launch: occupancy query says %d\n", per_cu); }
        (void)hipGetLastError();
        grid = cus;
        if (grid != 256) fprintf(stderr, "kernel_launch: %d CUs (built for 256)\n", grid);
    }
    if (grid < 0) return;
    (void)hipMemsetAsync((char*)d_ws + WS_CTL, 0, CTL_ZERO_BYTES, stream);
    Args a{};
    for (int i = 0; i < 23; ++i) a.in[i] = (const float*)d_in[i];
    a.out = (float*)d_out; a.ws = (unsigned char*)d_ws;
#if MK_DEBUG
    (void)hipMemsetAsync((char*)d_ws + CTL_ZERO_BYTES, 0xFF, WS_END - CTL_ZERO_BYTES, stream);
    unsigned* flag = (unsigned*)((char*)d_ws + 32768);
    (void)hipMemsetAsync((char*)d_ws + 32768 + 8, 0xFF, 4, stream);
    unsigned char* w = (unsigned char*)d_ws;
#define CHK(ptr, n, kind, lim, code) hipLaunchKernelGGL(dbg_check, dim3(1024), dim3(256), 0, stream, (const void*)(ptr), (size_t)(n), kind, (float)(lim), (unsigned)(MK_DEBUG_SUB ? ((code) - c + 1) * ((p) == MK_DEBUG_SUB - 1) : c), flag)
    for (int p = 0; p < MK_MAX_PHASE; ++p) { a.ph_lo = p; a.ph_hi = p + 1; hipLaunchKernelGGL(fwd_kernel, dim3(grid), dim3(512), LDS_BYTES, stream, a);
        const int c = (p + 1) * MK_DEBUG_MUL;
        switch (p) {
        case 0: CHK(w + WS_MOD, 2 * 5 * 6144, 1, 1e4, c); CHK(w + WS_ROPE, 4096, 1, 1.01, c + 1); CHK(w + WS_WQKV, 3072 * 1024, 0, 1e3, c + 2); CHK(w + WS_WO, 1024 * 1024, 0, 1e3, c + 2); CHK(w + WS_WGIN, GIN_NP * 1024, 0, 1e3, c + 3); CHK(w + WS_WGOUT, 1024 * 1024, 0, 1e3, c + 3);
                CHK(w + WS_WGU, (size_t)64 * 2048 * 1024, 0, 1e3, c + 4); CHK(w + WS_WD, (size_t)64 * 1024 * 1024, 0, 1e3, c + 4); break;
        case 1: CHK(w + WS_T, (size_t)T0 * DM, 0, 1e4, c); break;
        case 2: CHK(w + WS_Q, (size_t)T0 * DM, 0, 1e4, c); CHK(w + WS_KC, (size_t)T0 * DM, 0, 1e4, c + 1); CHK(w + WS_VC, (size_t)T0 * DM, 0, 1e4, c + 2); break;
        case 3: CHK(w + WS_AO, (size_t)T0 * DM, 0, 1e3, c); break;
        case 4: CHK(w + WS_Y, (size_t)T0 * DM, 0, 1e4, c); break;
        case 5: CHK(w + WS_X1, (size_t)T0 * DM, 0, 1e3, c); CHK(w + WS_U, (size_t)T0 * DM, 0, 1e4, c + 1); CHK(w + WS_TOKG, (size_t)T0 * 4, 1, 1.01, c + 2); CHK(w + WS_TOKE, (size_t)T0 * 4, 2, 31, c + 3); CHK(w + WS_HIST, 256 * 32, 2, 600, c + 4); break;
        case 6: CHK(w + WS_TOKR, (size_t)T0 * 4, 2, MAXRB * 256 - 1, c); CHK(w + WS_BLKEXP + 4092, 1, 2, MAXRB, c + 1); break;
        case 9: CHK(w + WS_X2, (size_t)T0 * DM, 0, 1e3, c); CHK(w + WS_T, (size_t)T0 * DM, 0, 1e4, c + 1); break;
        case 10: CHK(w + WS_Q, (size_t)T0 * DM, 0, 1e4, c); CHK(w + WS_KC, (size_t)T0 * DM, 0, 1e4, c + 1); CHK(w + WS_VC, (size_t)T0 * DM, 0, 1e4, c + 2); CHK(w + WS_GZ, (size_t)T0 * 32, 1, 1e4, c + 3); break;
        case 11: CHK(w + WS_H, (size_t)32 * NPC * 256 * 128, 0, 1e5, c); CHK(w + WS_DEC, (size_t)32 * NPC * 128, 1, 1.01, c + 1); break;
        case 12: CHK(w + WS_H, (size_t)32 * NPC * 256 * 128, 0, 1e6, c); break;
        case 13: CHK(w + WS_AO, (size_t)TLAT * DM, 0, 1e4, c); break;
        case 14: CHK(w + WS_Y, (size_t)TLAT * DM, 0, 1e4, c); break;
        case 15: CHK(w + WS_X1, (size_t)TLAT * DM, 0, 1e3, c); CHK(w + WS_U, (size_t)TLAT * DM, 0, 1e4, c + 1); CHK(w + WS_TOKG, (size_t)TLAT * 4, 1, 1.01, c + 2); CHK(w + WS_TOKE, (size_t)TLAT * 4, 2, 31, c + 3); CHK(w + WS_HIST, 256 * 32, 2, 600, c + 4); break;
        case 16: CHK(w + WS_TOKR, (size_t)TLAT * 4, 2, MAXRB * 256 - 1, c); CHK(w + WS_BLKEXP + 4092, 1, 2, MAXRB, c + 1); break;
        case 19: CHK(d_out, (size_t)TLAT * DM, 1, 1e3, c); break;
        default: break;
        }
    }
    hipLaunchKernelGGL(dbg_report, dim3(1024), dim3(256), 0, stream, (float*)d_out, (size_t)TLAT * DM, (const unsigned*)flag);
#elif MK_PER_PHASE
    for (int p = 0; p < MK_MAX_PHASE; ++p) { a.ph_lo = p; a.ph_hi = p + 1; if (p == MK_PVAR_PH) { for (int rep = 0; rep < 2; ++rep) { a.ph_lo = p | (MK_PVAR << 8); hipLaunchKernelGGL(fwd_kernel, dim3(grid), dim3(512), LDS_BYTES, stream, a); } a.ph_lo = p; }
        for (int rep = 0; rep < ((p == MK_REP_PH) ? 1 + MK_REP_N : 1); ++rep) hipLaunchKernelGGL(fwd_kernel, dim3(grid), dim3(512), LDS_BYTES, stream, a);
        if (MK_PROBE_ATT >= 0 && p == 3) { a.ph_lo = 20; a.ph_hi = 21; hipLaunchKernelGGL(fwd_kernel, dim3(grid), dim3(512), LDS_BYTES, stream, a); } }
#else
    a.ph_lo = 0; a.ph_hi = NPHASE;
    hipLaunchKernelGGL(fwd_kernel, dim3(grid), dim3(512), LDS_BYTES, stream, a);
#endif
    const hipError_t le = hipPeekAtLastError();
    if (le != hipSuccess) fprintf(stderr, "kernel_launch: launch failed: %s\n", hipGetErrorName(le));
}
```
